# Optimizing an MI355X kernel written in HIP

```python
import jax
import jax.numpy as jnp
from jax import lax
import numpy as np

D_MODEL = 1024
BATCH = 8
SEQ = 2048
DEPTH = 4

CHUNK = 64
EPS = 1e-6
N_MOD = 6

D_HGRN = 512
D_S5 = 256
D_LRU = 256
D_MIX = D_HGRN + D_S5 + D_LRU

HGRN_HEADS = 4
HGRN_DK = D_HGRN // HGRN_HEADS

S5_GROUP = 16
S5_GROUPS = D_S5 // S5_GROUP
S5_STATE = 64
S5_DT_MIN = 0.001
S5_DT_MAX = 0.1

LRU_BLOCKS = 4
LRU_BLOCK = D_LRU // LRU_BLOCKS
CONV_W = 4
LRU_C = 8.0

PEER_HEADS = 8
N_KEYS = 128
N_EXPERTS = N_KEYS * N_KEYS
PEER_DQ = 256
PEER_TOPK = 16
PEER_BLOCK = 128

IN_COLS = 4 * D_HGRN + D_S5 + 2 * D_LRU
IN_SPLITS = (D_HGRN, 2 * D_HGRN, 3 * D_HGRN, 4 * D_HGRN, 4 * D_HGRN + D_S5, 4 * D_HGRN + D_S5 + D_LRU)

kernel_name = 'hybrid_hgrn2_s5_rglru_peer_adaln'


def _normalize(y):
    y32 = y.astype(jnp.float32)
    return y32 * lax.rsqrt(jnp.mean(y32 * y32, axis=-1, keepdims=True) + EPS)


def rms_norm(x, g):
    return (_normalize(x) * g.astype(jnp.float32)).astype(x.dtype)


def hgrn2_mixer(q, f_pre, i, g, lb):
    f32 = jnp.float32
    bsz, seq, _ = q.shape
    nc = seq // CHUNK
    lb = lb.astype(f32)
    qa = jax.nn.silu(q.astype(f32))
    f = lb + (1.0 - lb) * jax.nn.sigmoid(f_pre.astype(f32))
    logf = jnp.log(f)
    k = 1.0 - f
    v = i.astype(f32)

    def to_chunks(t):
        return t.reshape(bsz, nc, CHUNK, HGRN_HEADS, HGRN_DK).transpose(1, 0, 3, 2, 4)

    qc, kc, vc, gc = to_chunks(qa), to_chunks(k), to_chunks(v), to_chunks(logf)
    causal = jnp.tril(jnp.ones((CHUNK, CHUNK), dtype=bool))[None, None, :, :, None]

    def step(state, inp):
        qb, kb, vb, gb = inp
        b = jnp.cumsum(gb, axis=2)
        diff = b[:, :, :, None, :] - b[:, :, None, :, :]
        decay = jnp.exp(jnp.where(causal, diff, -jnp.inf))
        scores = jnp.einsum('bhtd,bhsd,bhtsd->bhts', qb, kb, decay)
        o = (jnp.einsum('bhts,bhsv->bhtv', scores, vb)
             + jnp.einsum('bhtd,bhdv->bhtv', qb * jnp.exp(b), state))
        b_last = b[:, :, -1:, :]
        state = (state * jnp.exp(b_last[:, :, 0, :, None])
                 + jnp.einsum('bhsd,bhsv->bhdv', kb * jnp.exp(b_last - b), vb))
        return state, o

    s0 = jnp.zeros((bsz, HGRN_HEADS, HGRN_DK, HGRN_DK), f32)
    _, o = lax.scan(step, s0, (qc, kc, vc, gc))
    o = o.transpose(1, 0, 3, 2, 4).reshape(bsz, seq, HGRN_HEADS, HGRN_DK)
    o = _normalize(o).reshape(bsz, seq, D_HGRN)
    return o * jax.nn.silu(g.astype(f32))


def s5_mixer(u, a_re, a_im, b_re, b_im, c_re, c_im, log_dt, d_skip, w_glu, b_glu):
    f32 = jnp.float32
    bsz, seq, _ = u.shape
    u32 = u.astype(f32).reshape(bsz, seq, S5_GROUPS, S5_GROUP)
    lam_re = jnp.minimum(a_re.astype(f32), -1e-4)
    lam_im = a_im.astype(f32)
    dt = jnp.exp(log_dt.astype(f32))[:, None]
    mag = jnp.exp(lam_re * dt)
    ab_re = mag * jnp.cos(lam_im * dt)
    ab_im = mag * jnp.sin(lam_im * dt)
    den = lam_re * lam_re + lam_im * lam_im
    nr = ab_re - 1.0
    z_re = (nr * lam_re + ab_im * lam_im) / den
    z_im = (ab_im * lam_re - nr * lam_im) / den
    br = b_re.astype(f32)
    bi = b_im.astype(f32)
    bb_re = z_re[..., None] * br - z_im[..., None] * bi
    bb_im = z_re[..., None] * bi + z_im[..., None] * br
    bu_re = jnp.einsum('blgc,gpc->blgp', u32, bb_re)
    bu_im = jnp.einsum('blgc,gpc->blgp', u32, bb_im)
    a_full_re = jnp.broadcast_to(ab_re, bu_re.shape)
    a_full_im = jnp.broadcast_to(ab_im, bu_im.shape)

    def combine(e1, e2):
        a1r, a1i, b1r, b1i = e1
        a2r, a2i, b2r, b2i = e2
        return (a2r * a1r - a2i * a1i,
                a2r * a1i + a2i * a1r,
                a2r * b1r - a2i * b1i + b2r,
                a2r * b1i + a2i * b1r + b2i)

    _, _, xr, xi = lax.associative_scan(combine, (a_full_re, a_full_im, bu_re, bu_im), axis=1)
    y = (jnp.einsum('blgp,gcp->blgc', xr, c_re.astype(f32))
         - jnp.einsum('blgp,gcp->blgc', xi, c_im.astype(f32)))
    y = (y + d_skip.astype(f32).reshape(S5_GROUPS, S5_GROUP) * u32).reshape(bsz, seq, D_S5)
    z = jax.nn.gelu(y)
    return z * jax.nn.sigmoid(z @ w_glu.astype(f32) + b_glu.astype(f32))


def rglru_mixer(xb, zb, conv_w, conv_b, w_a, b_a, w_x, b_x, lam):
    f32 = jnp.float32
    bsz, seq, _ = xb.shape
    x32 = xb.astype(f32)
    rhs = conv_w.astype(f32)[:, None, :]
    xc = lax.conv_general_dilated(x32, rhs, window_strides=(1,), padding=[(CONV_W - 1, 0)],
                                  dimension_numbers=('NWC', 'WIO', 'NWC'),
                                  feature_group_count=D_LRU) + conv_b.astype(f32)
    xblk = xc.reshape(bsz, seq, LRU_BLOCKS, LRU_BLOCK)
    r = jax.nn.sigmoid(jnp.einsum('blhi,hij->blhj', xblk, w_a.astype(f32)).reshape(bsz, seq, D_LRU)
                       + b_a.astype(f32))
    ig = jax.nn.sigmoid(jnp.einsum('blhi,hij->blhj', xblk, w_x.astype(f32)).reshape(bsz, seq, D_LRU)
                        + b_x.astype(f32))
    log_a = -LRU_C * r * jax.nn.softplus(-lam.astype(f32))
    a = jnp.exp(log_a)
    bterm = jnp.sqrt(-jnp.expm1(2.0 * log_a)) * (ig * xc)

    def combine(e1, e2):
        a1, b1 = e1
        a2, b2 = e2
        return a1 * a2, a2 * b1 + b2

    _, h = lax.associative_scan(combine, (a, bterm), axis=1)
    return h * jax.nn.gelu(zb.astype(f32))


def peer_ffn(h, w_q, sub_keys, u_tab, v_tab):
    f32 = jnp.float32
    bsz, seq, dm = h.shape
    ntok = bsz * seq
    ht = h.reshape(ntok, dm)
    q = (ht @ w_q).astype(f32).reshape(ntok, PEER_HEADS, 2, PEER_DQ // 2)
    s = jnp.einsum('thpd,pkd->thpk', q, sub_keys.astype(f32))
    s_top, i_top = lax.top_k(s, PEER_TOPK)
    cand = s_top[:, :, 0, :, None] + s_top[:, :, 1, None, :]
    cand_idx = i_top[:, :, 0, :, None] * N_KEYS + i_top[:, :, 1, None, :]
    best, pos = lax.top_k(cand.reshape(ntok, PEER_HEADS, PEER_TOPK * PEER_TOPK), PEER_TOPK)
    experts = jnp.take_along_axis(cand_idx.reshape(ntok, PEER_HEADS, PEER_TOPK * PEER_TOPK), pos, axis=-1)
    gates = jax.nn.softmax(best, axis=-1)
    nb = ntok // PEER_BLOCK

    def block(args):
        hb, eb, gb = args
        act = jax.nn.gelu(jnp.einsum('td,thkd->thk', hb.astype(f32), u_tab[eb].astype(f32)))
        return jnp.einsum('thk,thkd->td', gb * act, v_tab[eb].astype(f32))

    out = lax.map(block, (ht.reshape(nb, PEER_BLOCK, dm),
                          experts.reshape(nb, PEER_BLOCK, PEER_HEADS, PEER_TOPK),
                          gates.reshape(nb, PEER_BLOCK, PEER_HEADS, PEER_TOPK)))
    return out.reshape(bsz, seq, dm).astype(h.dtype)


def setup_inputs(seed: int = 0) -> dict:
    key = jax.random.key(seed)
    ks = iter(jax.random.split(key, 40))
    nrm = lambda shape, scale: jax.random.normal(next(ks), shape, jnp.float32) * scale
    gain = lambda shape: 1.0 + nrm(shape, 0.05)
    inp = {}
    inp['x'] = nrm((BATCH, SEQ, D_MODEL), 1.0)
    inp['c'] = nrm((BATCH, D_MODEL), 1.0)
    inp['w_mod'] = nrm((DEPTH, D_MODEL, N_MOD * D_MODEL), 0.5 * D_MODEL ** -0.5)
    inp['b_mod'] = nrm((DEPTH, N_MOD * D_MODEL), 0.02)
    inp['g_mix'] = gain((DEPTH, D_MODEL))
    inp['w_in'] = nrm((DEPTH, D_MODEL, IN_COLS), D_MODEL ** -0.5)
    inp['hgrn_lb_logits'] = nrm((DEPTH, D_HGRN), 0.1)
    inp['s5_a_re'] = -0.5 + nrm((DEPTH, S5_GROUPS, S5_STATE), 0.01)
    inp['s5_a_im'] = (jnp.pi * jnp.arange(S5_STATE, dtype=jnp.float32))[None, None, :] + nrm((DEPTH, S5_GROUPS, S5_STATE), 0.01)
    inp['s5_b_re'] = nrm((DEPTH, S5_GROUPS, S5_STATE, S5_GROUP), (2.0 * S5_GROUP) ** -0.5)
    inp['s5_b_im'] = nrm((DEPTH, S5_GROUPS, S5_STATE, S5_GROUP), (2.0 * S5_GROUP) ** -0.5)
    inp['s5_c_re'] = nrm((DEPTH, S5_GROUPS, S5_GROUP, S5_STATE), (2.0 * S5_STATE) ** -0.5)
    inp['s5_c_im'] = nrm((DEPTH, S5_GROUPS, S5_GROUP, S5_STATE), (2.0 * S5_STATE) ** -0.5)
    inp['s5_log_dt'] = jax.random.uniform(next(ks), (DEPTH, S5_GROUPS), jnp.float32,
                                          np.log(S5_DT_MIN), np.log(S5_DT_MAX))
    inp['s5_d'] = nrm((DEPTH, D_S5), 1.0)
    inp['s5_w_glu'] = nrm((DEPTH, D_S5, D_S5), D_S5 ** -0.5)
    inp['s5_b_glu'] = nrm((DEPTH, D_S5), 0.02)
    inp['lru_conv_w'] = nrm((DEPTH, CONV_W, D_LRU), CONV_W ** -0.5)
    inp['lru_conv_b'] = nrm((DEPTH, D_LRU), 0.02)
    inp['lru_w_a'] = nrm((DEPTH, LRU_BLOCKS, LRU_BLOCK, LRU_BLOCK), LRU_BLOCK ** -0.5)
    inp['lru_b_a'] = nrm((DEPTH, D_LRU), 0.02)
    inp['lru_w_x'] = nrm((DEPTH, LRU_BLOCKS, LRU_BLOCK, LRU_BLOCK), LRU_BLOCK ** -0.5)
    inp['lru_b_x'] = nrm((DEPTH, D_LRU), 0.02)
    a_c = jax.random.uniform(next(ks), (DEPTH, D_LRU), jnp.float32, 0.9, 0.999)
    sig = a_c ** (1.0 / LRU_C)
    inp['lru_lambda'] = jnp.log(sig) - jnp.log1p(-sig)
    inp['g_branch'] = gain((DEPTH, D_MIX))
    inp['w_out'] = nrm((DEPTH, D_MIX, D_MODEL), D_MIX ** -0.5)
    inp['g_ffn'] = gain((DEPTH, D_MODEL))
    inp['peer_w_q'] = nrm((DEPTH, D_MODEL, PEER_HEADS * PEER_DQ), D_MODEL ** -0.5)
    inp['peer_sub_keys'] = nrm((DEPTH, 2, N_KEYS, PEER_DQ // 2), (PEER_DQ // 2) ** -0.5)
    inp['peer_u'] = nrm((DEPTH, N_EXPERTS, D_MODEL), D_MODEL ** -0.5)
    inp['peer_v'] = nrm((DEPTH, N_EXPERTS, D_MODEL), (PEER_HEADS * PEER_TOPK) ** -0.5)
    inp['g_final'] = gain((D_MODEL,))
    return inp


def reference(x, c, w_mod, b_mod, g_mix, w_in, hgrn_lb_logits, s5_a_re, s5_a_im, s5_b_re, s5_b_im,
              s5_c_re, s5_c_im, s5_log_dt, s5_d, s5_w_glu, s5_b_glu, lru_conv_w, lru_conv_b,
              lru_w_a, lru_b_a, lru_w_x, lru_b_x, lru_lambda, g_branch, w_out, g_ffn,
              peer_w_q, peer_sub_keys, peer_u, peer_v, g_final):
    cond = jax.nn.silu(c)
    lb_soft = jax.nn.softmax(hgrn_lb_logits.astype(jnp.float32), axis=0)
    lb_all = jnp.cumsum(lb_soft, axis=0) - lb_soft[0:1]
    for l in range(DEPTH):
        mod = (cond @ w_mod[l] + b_mod[l])[:, None, :]
        sh1, sc1, gt1, sh2, sc2, gt2 = jnp.split(mod, N_MOD, axis=-1)
        h = rms_norm(x, g_mix[l]) * (1.0 + sc1) + sh1
        p = h @ w_in[l]
        q_a, f_a, i_a, g_a, u_b, x_c, z_c = jnp.split(p, IN_SPLITS, axis=-1)
        y_a = hgrn2_mixer(q_a, f_a, i_a, g_a, lb_all[l])
        y_b = s5_mixer(u_b, s5_a_re[l], s5_a_im[l], s5_b_re[l], s5_b_im[l], s5_c_re[l], s5_c_im[l],
                       s5_log_dt[l], s5_d[l], s5_w_glu[l], s5_b_glu[l])
        y_c = rglru_mixer(x_c, z_c, lru_conv_w[l], lru_conv_b[l], lru_w_a[l], lru_b_a[l],
                          lru_w_x[l], lru_b_x[l], lru_lambda[l])
        y = jnp.concatenate([_normalize(y_a), _normalize(y_b), _normalize(y_c)], axis=-1)
        y = (y * g_branch[l].astype(jnp.float32)).astype(x.dtype)
        x = x + gt1 * (y @ w_out[l])
        h2 = rms_norm(x, g_ffn[l]) * (1.0 + sc2) + sh2
        x = x + gt2 * peer_ffn(h2, peer_w_q[l], peer_sub_keys[l], peer_u[l], peer_v[l])
    return rms_norm(x, g_final)
```

```cpp
#include <hip/hip_runtime.h>
#include <hip/hip_cooperative_groups.h>
#include <cstdio>
namespace cg = cooperative_groups;

typedef unsigned short u16;
using bf16x8 = __attribute__((ext_vector_type(8))) short;
using f32x4 = __attribute__((ext_vector_type(4))) float;
using u32x4 = __attribute__((ext_vector_type(4))) unsigned;

#define NTOK 16384
#define EPSF 1e-6f
#define NTHR 256

constexpr size_t OFF_WINT = 0;
constexpr size_t OFF_WOUTT = OFF_WINT + 4ull * 2816 * 1024 * 2;
constexpr size_t OFF_WQT = OFF_WOUTT + 4ull * 1024 * 1024 * 2;
constexpr size_t OFF_WGT = OFF_WQT + 4ull * 2048 * 1024 * 2;
constexpr size_t OFF_KEYS = OFF_WGT + 4ull * 256 * 256 * 2;
constexpr size_t OFF_UB = OFF_KEYS + 4ull * 2 * 128 * 128 * 2;
constexpr size_t OFF_VB = OFF_UB + 134217728ull;
constexpr size_t OFF_MOD = OFF_VB + 134217728ull;
constexpr size_t OFF_LB = OFF_MOD + 786432;
constexpr size_t OFF_S5A = OFF_LB + 8192;
constexpr size_t OFF_S5BB = OFF_S5A + 32768;
constexpr size_t OFF_SSQ = OFF_S5BB + 524288;
constexpr size_t OFF_XRES = OFF_SSQ + 1048576;
constexpr size_t OFF_HBUF = OFF_XRES + 67108864;
constexpr size_t OFF_PBUF = OFF_HBUF + 33554432;
constexpr size_t OFF_YBUF = OFF_PBUF + 184549376;
constexpr size_t OFF_QBUF = OFF_YBUF + 33554432;
constexpr size_t OFF_STOP = OFF_QBUF + 67108864;
constexpr size_t OFF_OBUF = OFF_STOP + 16777216;
constexpr size_t OFF_QG = OFF_OBUF + 33554432;
constexpr size_t OFF_SLOC = OFF_QG + 16777216;
constexpr size_t OFF_ST = OFF_SLOC + 67108864;
constexpr size_t OFF_DEC = OFF_ST + 33554432;
constexpr size_t OFF_S5E = OFF_DEC + 524288;
constexpr size_t OFF_S5XS = OFF_S5E + 2097152;
constexpr size_t OFF_ZBUF = OFF_S5XS + 2097152;
constexpr size_t OFF_HLOC = OFF_ZBUF + 8388608;
constexpr size_t OFF_PCUM = OFF_HLOC + 16777216;
constexpr size_t OFF_HST = OFF_PCUM + 16777216;
constexpr size_t WS_TOTAL = OFF_HST + 262144;
static_assert(WS_TOTAL <= (1ull << 30), "workspace too large");

struct Params {
  const float* in[32];
  float* out;
  char* ws;
};

enum { I_X = 0, I_C, I_WMOD, I_BMOD, I_GMIX, I_WIN, I_LBL, I_S5ARE, I_S5AIM, I_S5BRE, I_S5BIM, I_S5CRE, I_S5CIM,
       I_S5LOGDT, I_S5D, I_S5WGLU, I_S5BGLU, I_CONVW, I_CONVB, I_WA, I_BA, I_WX, I_BX, I_LAM, I_GBR, I_WOUT,
       I_GFFN, I_WQ, I_KEYS, I_U, I_V, I_GFINAL };

__device__ __forceinline__ int otid() {
  int t = threadIdx.x;
  asm volatile("" : "+v"(t));
  return t;
}
__device__ __forceinline__ u16 f2bf(float f) {
  unsigned u = __float_as_uint(f);
  u += 0x7fffu + ((u >> 16) & 1u);
  return (u16)(u >> 16);
}
__device__ __forceinline__ float bf2f(u16 h) { return __uint_as_float(((unsigned)h) << 16); }
__device__ __forceinline__ unsigned pack2(float a, float b) { return (unsigned)f2bf(a) | ((unsigned)f2bf(b) << 16); }
__device__ __forceinline__ float bflo(unsigned w) { return __uint_as_float(w << 16); }
__device__ __forceinline__ float bfhi(unsigned w) { return __uint_as_float(w & 0xffff0000u); }
__device__ __forceinline__ float sigmoidf_(float x) { return 1.f / (1.f + __expf(-x)); }
__device__ __forceinline__ float siluf_(float x) { return x * sigmoidf_(x); }
__device__ __forceinline__ float geluf_(float x) {
  float u = 0.7978845608028654f * (x + 0.044715f * x * x * x);
  float t = __expf(2.f * u);
  float th = 1.f - 2.f / (t + 1.f);
  return 0.5f * x * (1.f + th);
}
__device__ __forceinline__ float wave_sum(float v) {
#pragma unroll
  for (int o = 32; o > 0; o >>= 1) v += __shfl_xor(v, o);
  return v;
}

template <int BM, class KH, class EP>
__device__ __forceinline__ void gemm_tile(const u16* __restrict__ A, int lda, const u16* __restrict__ Bt, int ldb,
                                          int K, char* smem, KH&& kh, EP&& ep) {
  constexpr int MT = BM / 32;
  constexpr int NA = BM * 8 / NTHR;
  u16* As = (u16*)smem;
  u16* Bs = As + BM * 72;
  const int tid = otid(), lane = tid & 63, wid = tid >> 6, fr = lane & 15, fq = lane >> 4, wr = wid >> 1,
            wc = wid & 1;
  u32x4 ra[NA], rb[4];
  f32x4 acc[MT][4];
#pragma unroll
  for (int m = 0; m < MT; m++)
#pragma unroll
    for (int n = 0; n < 4; n++) acc[m][n] = f32x4{0.f, 0.f, 0.f, 0.f};
#pragma unroll
  for (int i = 0; i < NA; i++) {
    int q = tid + i * NTHR, r = q >> 3, kc = q & 7;
    ra[i] = *(const u32x4*)(A + (size_t)r * lda + kc * 8);
  }
#pragma unroll
  for (int i = 0; i < 4; i++) {
    int q = tid + i * NTHR, r = q >> 3, kc = q & 7;
    rb[i] = *(const u32x4*)(Bt + (size_t)r * ldb + kc * 8);
  }
  const int nk = K >> 6;
  for (int kt = 0; kt < nk; kt++) {
    __syncthreads();
#pragma unroll
    for (int i = 0; i < NA; i++) {
      int q = tid + i * NTHR, r = q >> 3, kc = q & 7;
      *(u32x4*)(As + r * 72 + kc * 8) = ra[i];
    }
#pragma unroll
    for (int i = 0; i < 4; i++) {
      int q = tid + i * NTHR, r = q >> 3, kc = q & 7;
      *(u32x4*)(Bs + r * 72 + kc * 8) = rb[i];
    }
    __syncthreads();
    if (kt + 1 < nk) {
      const int k0 = (kt + 1) << 6;
#pragma unroll
      for (int i = 0; i < NA; i++) {
        int q = tid + i * NTHR, r = q >> 3, kc = q & 7;
        ra[i] = *(const u32x4*)(A + (size_t)r * lda + k0 + kc * 8);
      }
#pragma unroll
      for (int i = 0; i < 4; i++) {
        int q = tid + i * NTHR, r = q >> 3, kc = q & 7;
        rb[i] = *(const u32x4*)(Bt + (size_t)r * ldb + k0 + kc * 8);
      }
    }
#pragma unroll
    for (int ks = 0; ks < 2; ks++) {
      bf16x8 af[MT], bfr[4];
#pragma unroll
      for (int m = 0; m < MT; m++)
        af[m] = *(const bf16x8*)(As + (wr * (BM / 2) + m * 16 + fr) * 72 + ks * 32 + fq * 8);
#pragma unroll
      for (int n = 0; n < 4; n++) bfr[n] = *(const bf16x8*)(Bs + (wc * 64 + n * 16 + fr) * 72 + ks * 32 + fq * 8);
#pragma unroll
      for (int m = 0; m < MT; m++)
#pragma unroll
        for (int n = 0; n < 4; n++) acc[m][n] = __builtin_amdgcn_mfma_f32_16x16x32_bf16(af[m], bfr[n], acc[m][n], 0, 0, 0);
    }
    kh(kt, acc);
  }
  ep(acc);
}

struct NoHook {
  template <class T>
  __device__ __forceinline__ void operator()(int, T&) const {}
};

__device__ void transpose_tile(const float* __restrict__ src, int ld_src, u16* __restrict__ dst, int ld_dst, int k0,
                               int n0, const float* __restrict__ rowscale, char* smem) {
  float(*T)[65] = (float(*)[65])smem;
  const int tid = otid();
  __syncthreads();
#pragma unroll 4
  for (int i = 0; i < 16; i++) {
    int r = (tid >> 6) + 4 * i;
    float v = src[(size_t)(k0 + r) * ld_src + n0 + (tid & 63)];
    if (rowscale) v *= rowscale[k0 + r];
    T[r][tid & 63] = v;
  }
  __syncthreads();
#pragma unroll 4
  for (int i = 0; i < 16; i++) {
    int n = (tid >> 6) + 4 * i;
    dst[(size_t)(n0 + n) * ld_dst + k0 + (tid & 63)] = f2bf(T[tid & 63][n]);
  }
}

constexpr int NP_UV = 16384;
constexpr int NP_TIN = 2816;
constexpr int NP_TOUT = 1024;
constexpr int NP_TQ = 2048;
constexpr int NP_TG = 64;
constexpr int NP_MOD = 384;
constexpr int NP_LB = 1;
constexpr int NP_S5 = 4;
constexpr int NP_KEYS = 8;
constexpr int NP_SSQ = 16;
constexpr int NP_TOTAL = NP_UV + NP_TIN + NP_TOUT + NP_TQ + NP_TG + NP_MOD + NP_LB + NP_S5 + NP_KEYS + NP_SSQ;

__device__ void phase_prep(const Params& P, char* smem) {
  const int tid = otid();
  char* ws = P.ws;
  for (int item = blockIdx.x; item < NP_TOTAL; item += gridDim.x) {
    int idx = item;
    if (idx < NP_UV) {
      const float* src = (idx < 8192) ? P.in[I_U] : P.in[I_V];
      u16* dst = (u16*)(ws + ((idx < 8192) ? OFF_UB : OFF_VB));
      size_t base = (size_t)(idx & 8191) * 8192;
#pragma unroll
      for (int it = 0; it < 4; it++) {
        size_t e = base + (size_t)(it * NTHR + tid) * 8;
        float4 a = *(const float4*)(src + e);
        float4 b = *(const float4*)(src + e + 4);
        uint4 o;
        o.x = pack2(a.x, a.y); o.y = pack2(a.z, a.w); o.z = pack2(b.x, b.y); o.w = pack2(b.z, b.w);
        *(uint4*)(dst + e) = o;
      }
      continue;
    }
    idx -= NP_UV;
    if (idx < NP_TIN) {
      int l = idx / 704, r = idx % 704, kt = r / 44, nt = r % 44;
      transpose_tile(P.in[I_WIN] + (size_t)l * 1024 * 2816, 2816, (u16*)(ws + OFF_WINT) + (size_t)l * 2816 * 1024, 1024,
                     kt * 64, nt * 64, nullptr, smem);
      continue;
    }
    idx -= NP_TIN;
    if (idx < NP_TOUT) {
      int l = idx >> 8, r = idx & 255, kt = r >> 4, nt = r & 15;
      transpose_tile(P.in[I_WOUT] + (size_t)l * 1048576, 1024, (u16*)(ws + OFF_WOUTT) + (size_t)l * 1048576, 1024,
                     kt * 64, nt * 64, P.in[I_GBR] + l * 1024, smem);
      continue;
    }
    idx -= NP_TOUT;
    if (idx < NP_TQ) {
      int l = idx >> 9, r = idx & 511, kt = r >> 5, nt = r & 31;
      transpose_tile(P.in[I_WQ] + (size_t)l * 1024 * 2048, 2048, (u16*)(ws + OFF_WQT) + (size_t)l * 2048 * 1024, 1024,
                     kt * 64, nt * 64, nullptr, smem);
      continue;
    }
    idx -= NP_TQ;
    if (idx < NP_TG) {
      int l = idx >> 4, r = idx & 15, kt = r >> 2, nt = r & 3;
      transpose_tile(P.in[I_S5WGLU] + (size_t)l * 65536, 256, (u16*)(ws + OFF_WGT) + (size_t)l * 65536, 256, kt * 64,
                     nt * 64, nullptr, smem);
      continue;
    }
    idx -= NP_TG;
    if (idx < NP_MOD) {
      int l = idx / 96, n0 = (idx % 96) * 64;
      float* cs = (float*)smem;
      float* red = cs + 8192;
      __syncthreads();
      for (int i = tid; i < 8192; i += NTHR) cs[i] = siluf_(P.in[I_C][i]);
      __syncthreads();
      int j = tid & 63, kq = tid >> 6;
      float a[8];
#pragma unroll
      for (int b = 0; b < 8; b++) a[b] = 0.f;
      const float* w = P.in[I_WMOD] + (size_t)l * 1024 * 6144 + n0 + j;
      for (int k = kq * 256; k < kq * 256 + 256; k++) {
        float wv = w[(size_t)k * 6144];
#pragma unroll
        for (int b = 0; b < 8; b++) a[b] += cs[b * 1024 + k] * wv;
      }
#pragma unroll
      for (int b = 0; b < 8; b++) red[(kq * 8 + b) * 64 + j] = a[b];
      __syncthreads();
      for (int o = tid; o < 512; o += NTHR) {
        int b = o >> 6, jj = o & 63;
        float s = red[(0 * 8 + b) * 64 + jj] + red[(1 * 8 + b) * 64 + jj] + red[(2 * 8 + b) * 64 + jj] +
                  red[(3 * 8 + b) * 64 + jj];
        s += P.in[I_BMOD][l * 6144 + n0 + jj];
        ((float*)(ws + OFF_MOD))[(size_t)(l * 8 + b) * 6144 + n0 + jj] = s;
      }
      continue;
    }
    idx -= NP_MOD;
    if (idx < NP_LB) {
      float* LB = (float*)(ws + OFF_LB);
      for (int ch = tid; ch < 512; ch += NTHR) {
        float v0 = P.in[I_LBL][ch], v1 = P.in[I_LBL][512 + ch], v2 = P.in[I_LBL][1024 + ch], v3 = P.in[I_LBL][1536 + ch];
        float m = fmaxf(fmaxf(v0, v1), fmaxf(v2, v3));
        float e0 = expf(v0 - m), e1 = expf(v1 - m), e2 = expf(v2 - m), e3 = expf(v3 - m);
        float inv = 1.f / (e0 + e1 + e2 + e3);
        LB[ch] = 0.f;
        LB[512 + ch] = e1 * inv;
        LB[1024 + ch] = (e1 + e2) * inv;
        LB[1536 + ch] = (e1 + e2 + e3) * inv;
      }
      continue;
    }
    idx -= NP_LB;
    if (idx < NP_S5) {
      int l = idx;
      float* SA = (float*)(ws + OFF_S5A);
      float* SB = (float*)(ws + OFF_S5BB);
      for (int gp = tid; gp < 1024; gp += NTHR) {
        int g = gp >> 6;
        float lre = fminf(P.in[I_S5ARE][l * 1024 + gp], -1e-4f);
        float lim = P.in[I_S5AIM][l * 1024 + gp];
        float dt = expf(P.in[I_S5LOGDT][l * 16 + g]);
        float mag = expf(lre * dt);
        float abr = mag * cosf(lim * dt), abi = mag * sinf(lim * dt);
        float den = lre * lre + lim * lim;
        float nr = abr - 1.f;
        float zr = (nr * lre + abi * lim) / den;
        float zi = (abi * lre - nr * lim) / den;
        SA[(l * 1024 + gp) * 2 + 0] = abr;
        SA[(l * 1024 + gp) * 2 + 1] = abi;
        const float* br = P.in[I_S5BRE] + (size_t)(l * 1024 + gp) * 16;
        const float* bi = P.in[I_S5BIM] + (size_t)(l * 1024 + gp) * 16;
        float* o = SB + (size_t)(l * 1024 + gp) * 32;
#pragma unroll
        for (int c = 0; c < 16; c++) {
          o[c] = zr * br[c] - zi * bi[c];
          o[16 + c] = zr * bi[c] + zi * br[c];
        }
      }
      continue;
    }
    idx -= NP_S5;
    if (idx < NP_KEYS) {
      u16* KB = (u16*)(ws + OFF_KEYS);
      for (int i = 0; i < 64; i++) {
        int e = idx * 16384 + i * NTHR + tid;
        KB[e] = f2bf(P.in[I_KEYS][e]);
      }
      continue;
    }
    idx -= NP_KEYS;
    {
      float* SS = (float*)(ws + OFF_SSQ);
      for (int i = 0; i < 64; i++) SS[idx * 16384 + i * NTHR + tid] = 0.f;
    }
  }
}

__device__ void phase_norm(const float* __restrict__ xsrc, const float* __restrict__ g, const float* __restrict__ modl,
                           int sh_off, int sc_off, u16* __restrict__ hb) {
  const int lane = otid() & 63;
  const int wave = (blockIdx.x * NTHR + otid()) >> 6, nw = gridDim.x * 4;
  for (int t = wave; t < NTOK; t += nw) {
    const float4* xr = (const float4*)(xsrc + (size_t)t * 1024);
    float4 v[4];
    float ss = 0.f;
#pragma unroll
    for (int i = 0; i < 4; i++) {
      v[i] = xr[lane + 64 * i];
      ss += v[i].x * v[i].x + v[i].y * v[i].y + v[i].z * v[i].z + v[i].w * v[i].w;
    }
    ss = wave_sum(ss);
    float rstd = rsqrtf(ss * (1.f / 1024.f) + EPSF);
    const float* mb = modl + (size_t)(t >> 11) * 6144;
#pragma unroll
    for (int i = 0; i < 4; i++) {
      int col = (lane + 64 * i) * 4;
      float4 g4 = *(const float4*)(g + col);
      float4 sc = *(const float4*)(mb + sc_off + col);
      float4 sh = *(const float4*)(mb + sh_off + col);
      float h0 = v[i].x * rstd * g4.x * (1.f + sc.x) + sh.x;
      float h1 = v[i].y * rstd * g4.y * (1.f + sc.y) + sh.y;
      float h2 = v[i].z * rstd * g4.z * (1.f + sc.z) + sh.z;
      float h3 = v[i].w * rstd * g4.w * (1.f + sc.w) + sh.w;
      uint2 o;
      o.x = pack2(h0, h1);
      o.y = pack2(h2, h3);
      *(uint2*)(hb + (size_t)t * 1024 + col) = o;
    }
  }
}

__device__ void phase_gemm_in(const Params& P, int l, char* smem) {
  char* ws = P.ws;
  const u16* HB = (const u16*)(ws + OFF_HBUF);
  const u16* W = (const u16*)(ws + OFF_WINT) + (size_t)l * 2816 * 1024;
  float* PB = (float*)(ws + OFF_PBUF);
  const int lane = otid() & 63, wid = otid() >> 6, fr = lane & 15, fq = lane >> 4, wr = wid >> 1, wc = wid & 1;
  for (int tile = blockIdx.x; tile < 128 * 22; tile += gridDim.x) {
    int mt = tile / 22, nt = tile % 22;
    float* out = PB + (size_t)(mt * 128) * 2816 + nt * 128;
    gemm_tile<128>(HB + (size_t)mt * 128 * 1024, 1024, W + (size_t)nt * 128 * 1024, 1024, 1024, smem, NoHook(),
                   [&](f32x4(&acc)[4][4]) {
#pragma unroll
                     for (int m = 0; m < 4; m++)
#pragma unroll
                       for (int n = 0; n < 4; n++)
#pragma unroll
                         for (int j = 0; j < 4; j++)
                           out[(size_t)(wr * 64 + m * 16 + fq * 4 + j) * 2816 + wc * 64 + n * 16 + fr] = acc[m][n][j];
                   });
  }
}

__device__ void hgrn_local(const Params& P, int l, int item, char* smem) {
  char* ws = P.ws;
  const int c = item & 31, h = (item >> 5) & 3, b = item >> 7;
  const int t0 = b * 2048 + c * 64;
  int tid = otid();
  asm volatile("" : "+v"(tid));
  const int d = tid & 127, half = tid >> 7;
  const float* pb = (const float*)(ws + OFF_PBUF) + (size_t)t0 * 2816;
  const int lane = tid & 63, w = tid >> 6, fr = lane & 15, fq = lane >> 4;
  const float lbv = ((const float*)(ws + OFF_LB))[l * 512 + h * 128 + d];
  u16* Aq = (u16*)smem;
  u16* BI = Aq + 64 * 136;
  u16* Sc = BI + 64 * 136;
  u16* vT = Sc + 64 * 72;
  float* anc = (float*)(vT + 128 * 72);
  u16* kdT = (u16*)smem;
  __syncthreads();
  float bb[32], kk[32];
  {
    float run = 0.f;
#pragma unroll
    for (int i = 0; i < 32; i++) {
      int t = half * 32 + i;
      float fp = pb[(size_t)t * 2816 + 512 + h * 128 + d];
      float f = lbv + (1.f - lbv) * sigmoidf_(fp);
      run += logf(f);
      bb[i] = run;
      kk[i] = 1.f - f;
      if ((i & 7) == 7) __builtin_amdgcn_sched_barrier(0);
    }
  }
  if (half == 0) {
    anc[d] = 0.f;
    anc[128 + d] = bb[15];
    anc[256 + d] = bb[31];
  }
  __syncthreads();
  if (half == 1) {
    float off = anc[256 + d];
#pragma unroll
    for (int i = 0; i < 32; i++) bb[i] += off;
    anc[384 + d] = bb[15];
    anc[512 + d] = bb[31];
  }
  __syncthreads();
  const float b31 = anc[256 + d], b63 = anc[512 + d];
  {
    u16* QG = (u16*)(ws + OFF_QG);
    const float a_lo = half ? b31 : 0.f;
    const float a_hi = bb[15];
#pragma unroll
    for (int i = 0; i < 32; i++) {
      int t = half * 32 + i;
      float q = pb[(size_t)t * 2816 + h * 128 + d];
      float qa = siluf_(q);
      float anchor = (i < 16) ? a_lo : a_hi;
      Aq[t * 136 + d] = f2bf(qa * __expf(bb[i] - anchor));
      QG[(size_t)(t0 + t) * 512 + h * 128 + d] = f2bf(qa * __expf(bb[i]));
      if ((i & 7) == 7) __builtin_amdgcn_sched_barrier(0);
    }
#pragma unroll
    for (int grp = 0; grp < 4; grp++) {
      float vv[8];
#pragma unroll
      for (int e = 0; e < 8; e++) vv[e] = pb[(size_t)(half * 32 + grp * 8 + e) * 2816 + 1024 + h * 128 + d];
      uint4 o;
      o.x = pack2(vv[0], vv[1]); o.y = pack2(vv[2], vv[3]); o.z = pack2(vv[4], vv[5]); o.w = pack2(vv[6], vv[7]);
      *(uint4*)(vT + d * 72 + half * 32 + grp * 8) = o;
      __builtin_amdgcn_sched_barrier(0);
    }
  }
  for (int I = 0; I < 4; I++) {
    __syncthreads();
    const float rI = anc[I * 128 + d];
#pragma unroll
    for (int i = 0; i < 32; i++) {
      int s = half * 32 + i;
      if (s < 16 * (I + 1)) BI[s * 136 + d] = f2bf(kk[i] * __expf(rI - bb[i]));
    }
    __syncthreads();
    if (w <= I) {
      f32x4 acc = f32x4{0.f, 0.f, 0.f, 0.f};
#pragma unroll
      for (int ks = 0; ks < 4; ks++) {
        bf16x8 a = *(const bf16x8*)(Aq + (16 * I + fr) * 136 + ks * 32 + fq * 8);
        bf16x8 bq = *(const bf16x8*)(BI + (16 * w + fr) * 136 + ks * 32 + fq * 8);
        acc = __builtin_amdgcn_mfma_f32_16x16x32_bf16(a, bq, acc, 0, 0, 0);
      }
#pragma unroll
      for (int j = 0; j < 4; j++) {
        float val = acc[j];
        if (w == I && fr > fq * 4 + j) val = 0.f;
        Sc[(16 * I + fq * 4 + j) * 72 + 16 * w + fr] = f2bf(val);
      }
    } else {
#pragma unroll
      for (int j = 0; j < 4; j++) Sc[(16 * I + fq * 4 + j) * 72 + 16 * w + fr] = 0;
    }
  }
  __syncthreads();
#pragma unroll
  for (int grp = 0; grp < 4; grp++) {
    float vv[8];
#pragma unroll
    for (int e = 0; e < 8; e++) vv[e] = kk[grp * 8 + e] * __expf(b63 - bb[grp * 8 + e]);
    uint4 o;
    o.x = pack2(vv[0], vv[1]); o.y = pack2(vv[2], vv[3]); o.z = pack2(vv[4], vv[5]); o.w = pack2(vv[6], vv[7]);
    *(uint4*)(kdT + d * 72 + half * 32 + grp * 8) = o;
  }
  {
    f32x4 oacc[4][2];
#pragma unroll
    for (int m = 0; m < 4; m++)
#pragma unroll
      for (int n = 0; n < 2; n++) oacc[m][n] = f32x4{0.f, 0.f, 0.f, 0.f};
#pragma unroll
    for (int ks = 0; ks < 2; ks++) {
      bf16x8 a[4], bq[2];
#pragma unroll
      for (int m = 0; m < 4; m++) a[m] = *(const bf16x8*)(Sc + (m * 16 + fr) * 72 + ks * 32 + fq * 8);
#pragma unroll
      for (int n = 0; n < 2; n++) bq[n] = *(const bf16x8*)(vT + ((2 * w + n) * 16 + fr) * 72 + ks * 32 + fq * 8);
#pragma unroll
      for (int m = 0; m < 4; m++)
#pragma unroll
        for (int n = 0; n < 2; n++) oacc[m][n] = __builtin_amdgcn_mfma_f32_16x16x32_bf16(a[m], bq[n], oacc[m][n], 0, 0, 0);
    }
    float* OB = (float*)(ws + OFF_OBUF);
#pragma unroll
    for (int m = 0; m < 4; m++)
#pragma unroll
      for (int n = 0; n < 2; n++)
#pragma unroll
        for (int j = 0; j < 4; j++)
          OB[(size_t)(t0 + m * 16 + fq * 4 + j) * 512 + h * 128 + (2 * w + n) * 16 + fr] = oacc[m][n][j];
  }
  __syncthreads();
  {
    f32x4 sacc[2][8];
#pragma unroll
    for (int m = 0; m < 2; m++)
#pragma unroll
      for (int n = 0; n < 8; n++) sacc[m][n] = f32x4{0.f, 0.f, 0.f, 0.f};
#pragma unroll
    for (int ks = 0; ks < 2; ks++) {
      bf16x8 a[2];
#pragma unroll
      for (int m = 0; m < 2; m++) a[m] = *(const bf16x8*)(vT + ((2 * w + m) * 16 + fr) * 72 + ks * 32 + fq * 8);
#pragma unroll
      for (int n = 0; n < 8; n++) {
        bf16x8 bq = *(const bf16x8*)(kdT + (n * 16 + fr) * 72 + ks * 32 + fq * 8);
#pragma unroll
        for (int m = 0; m < 2; m++) sacc[m][n] = __builtin_amdgcn_mfma_f32_16x16x32_bf16(a[m], bq, sacc[m][n], 0, 0, 0);
      }
    }
    float* SL = (float*)(ws + OFF_SLOC) + (size_t)((b * 4 + h) * 32 + c) * 16384;
#pragma unroll
    for (int m = 0; m < 2; m++)
#pragma unroll
      for (int n = 0; n < 8; n++)
#pragma unroll
        for (int j = 0; j < 4; j++) SL[((2 * w + m) * 16 + fq * 4 + j) * 128 + n * 16 + fr] = sacc[m][n][j];
    if (half == 1) ((float*)(ws + OFF_DEC))[((b * 4 + h) * 32 + c) * 128 + d] = __expf(b63);
  }
}

__device__ void hgrn_carry(const Params& P, int item) {
  char* ws = P.ws;
  const int bh = item >> 6, e = (item & 63) * 256 + otid(), d = e & 127;
  const float* SL = (const float*)(ws + OFF_SLOC);
  const float* DC = (const float*)(ws + OFF_DEC);
  u16* ST = (u16*)(ws + OFF_ST);
  float run = 0.f;
#pragma unroll 4
  for (int c = 0; c < 32; c++) {
    size_t base = (size_t)(bh * 32 + c) * 16384 + e;
    float loc = SL[base];
    ST[base] = f2bf(run);
    run = run * DC[(bh * 32 + c) * 128 + d] + loc;
  }
}

__device__ void hgrn_final(const Params& P, int l, int item, char* smem) {
  char* ws = P.ws;
  const int c = item & 31, h = (item >> 5) & 3, b = item >> 7;
  const int t0 = b * 2048 + c * 64;
  const int tid = otid(), lane = tid & 63, wid = tid >> 6, fr = lane & 15, fq = lane >> 4, wr = wid >> 1, wc = wid & 1;
  const u16* QG = (const u16*)(ws + OFF_QG) + (size_t)t0 * 512 + h * 128;
  const u16* ST = (const u16*)(ws + OFF_ST) + (size_t)((b * 4 + h) * 32 + c) * 16384;
  const float* OB = (const float*)(ws + OFF_OBUF) + (size_t)t0 * 512 + h * 128;
  float* tile = (float*)(smem + 27648);
  gemm_tile<64>(QG, 512, ST, 128, 128, smem, NoHook(), [&](f32x4(&acc)[2][4]) {
#pragma unroll
    for (int m = 0; m < 2; m++)
#pragma unroll
      for (int n = 0; n < 4; n++)
#pragma unroll
        for (int j = 0; j < 4; j++) {
          int r = wr * 32 + m * 16 + fq * 4 + j, cc = wc * 64 + n * 16 + fr;
          tile[r * 132 + cc] = acc[m][n][j] + OB[(size_t)r * 512 + cc];
        }
  });
  __syncthreads();
  const float* pb = (const float*)(ws + OFF_PBUF);
  u16* YB = (u16*)(ws + OFF_YBUF);
  float* SS = (float*)(ws + OFF_SSQ) + (size_t)l * NTOK * 4;
  for (int rr = 0; rr < 16; rr++) {
    int r = wid * 16 + rr, t = t0 + r;
    float o0 = tile[r * 132 + lane], o1 = tile[r * 132 + 64 + lane];
    float ss = wave_sum(o0 * o0 + o1 * o1);
    float rstd = rsqrtf(ss * (1.f / 128.f) + EPSF);
    float g0 = pb[(size_t)t * 2816 + 1536 + h * 128 + lane], g1 = pb[(size_t)t * 2816 + 1536 + h * 128 + 64 + lane];
    float y0 = o0 * rstd * siluf_(g0), y1 = o1 * rstd * siluf_(g1);
    YB[(size_t)t * 1024 + h * 128 + lane] = f2bf(y0);
    YB[(size_t)t * 1024 + h * 128 + 64 + lane] = f2bf(y1);
    float s2 = wave_sum(y0 * y0 + y1 * y1);
    if (lane == 0) atomicAdd(&SS[t * 4 + 0], s2);
  }
}

template <bool FINAL>
__device__ void s5_pass(const Params& P, int l, int item, char* smem) {
  char* ws = P.ws;
  const int cq = item & 7, g = (item >> 3) & 15, b = item >> 7;
  const int tid = otid(), lane = tid & 63, w = tid >> 6;
  const int c = cq * 4 + w;
  const int t0 = b * 2048 + c * 64;
  float* Cre = (float*)smem;
  float* Cim = Cre + 1024;
  float* ub = Cim + 1024 + w * 256;
  float2* xs = (float2*)(smem + 8192 + 4096) + w * (16 * 65);
  const float* pb = (const float*)(ws + OFF_PBUF);
  __syncthreads();
  if (FINAL) {
#pragma unroll
    for (int i = 0; i < 4; i++) {
      int idx = tid + i * NTHR, cc = idx >> 6, p = idx & 63;
      Cre[p * 16 + cc] = P.in[I_S5CRE][(size_t)(l * 16 + g) * 1024 + idx];
      Cim[p * 16 + cc] = P.in[I_S5CIM][(size_t)(l * 16 + g) * 1024 + idx];
    }
  }
  const float* SA = (const float*)(ws + OFF_S5A) + (size_t)((l * 16 + g) * 64 + lane) * 2;
  const float are = SA[0], aim = SA[1];
  float bbr[16], bbi[16];
  {
    const float4* SB = (const float4*)((const float*)(ws + OFF_S5BB) + (size_t)((l * 16 + g) * 64 + lane) * 32);
#pragma unroll
    for (int i = 0; i < 4; i++) {
      float4 v = SB[i];
      bbr[i * 4 + 0] = v.x; bbr[i * 4 + 1] = v.y; bbr[i * 4 + 2] = v.z; bbr[i * 4 + 3] = v.w;
      float4 u = SB[4 + i];
      bbi[i * 4 + 0] = u.x; bbi[i * 4 + 1] = u.y; bbi[i * 4 + 2] = u.z; bbi[i * 4 + 3] = u.w;
    }
  }
  float xr = 0.f, xi = 0.f;
  const size_t sidx = (size_t)((b * 16 + g) * 32 + c) * 64 + lane;
  if (FINAL) {
    float2 x0 = ((const float2*)(ws + OFF_S5XS))[sidx];
    xr = x0.x; xi = x0.y;
  }
  for (int sub = 0; sub < 4; sub++) {
    __syncthreads();
    {
      int tt = lane >> 2, cc = (lane & 3) * 4;
      float4 uv = *(const float4*)(pb + (size_t)(t0 + sub * 16 + tt) * 2816 + 2048 + g * 16 + cc);
      *(float4*)(ub + tt * 16 + cc) = uv;
    }
    __syncthreads();
#pragma unroll 4
    for (int tt = 0; tt < 16; tt++) {
      float br = 0.f, bi = 0.f;
#pragma unroll
      for (int q = 0; q < 4; q++) {
        float4 uv = *(const float4*)(ub + tt * 16 + q * 4);
        br += uv.x * bbr[q * 4 + 0] + uv.y * bbr[q * 4 + 1] + uv.z * bbr[q * 4 + 2] + uv.w * bbr[q * 4 + 3];
        bi += uv.x * bbi[q * 4 + 0] + uv.y * bbi[q * 4 + 1] + uv.z * bbi[q * 4 + 2] + uv.w * bbi[q * 4 + 3];
      }
      float nxr = are * xr - aim * xi + br;
      float nxi = are * xi + aim * xr + bi;
      xr = nxr; xi = nxi;
      if (FINAL) xs[tt * 65 + lane] = make_float2(xr, xi);
    }
    if (FINAL) {
      __syncthreads();
      int tt = lane >> 2, c4 = (lane & 3) * 4;
      float y0 = 0.f, y1 = 0.f, y2 = 0.f, y3 = 0.f;
#pragma unroll 8
      for (int p = 0; p < 64; p++) {
        float2 x = xs[tt * 65 + p];
        float4 cr = *(const float4*)(Cre + p * 16 + c4);
        float4 ci = *(const float4*)(Cim + p * 16 + c4);
        y0 += x.x * cr.x - x.y * ci.x;
        y1 += x.x * cr.y - x.y * ci.y;
        y2 += x.x * cr.z - x.y * ci.z;
        y3 += x.x * cr.w - x.y * ci.w;
      }
      float4 uv = *(const float4*)(ub + tt * 16 + c4);
      float4 dk = *(const float4*)(P.in[I_S5D] + l * 256 + g * 16 + c4);
      y0 = geluf_(y0 + dk.x * uv.x);
      y1 = geluf_(y1 + dk.y * uv.y);
      y2 = geluf_(y2 + dk.z * uv.z);
      y3 = geluf_(y3 + dk.w * uv.w);
      uint2 o;
      o.x = pack2(y0, y1);
      o.y = pack2(y2, y3);
      *(uint2*)((u16*)(ws + OFF_ZBUF) + (size_t)(t0 + sub * 16 + tt) * 256 + g * 16 + c4) = o;
    }
  }
  if (!FINAL) ((float2*)(ws + OFF_S5E))[sidx] = make_float2(xr, xi);
}

__device__ void s5_carry(const Params& P, int l, int item) {
  char* ws = P.ws;
  const int idx = item * NTHR + otid(), p = idx & 63, g = (idx >> 6) & 15, b = idx >> 10;
  const float* SA = (const float*)(ws + OFF_S5A) + (size_t)((l * 16 + g) * 64 + p) * 2;
  float ar = SA[0], ai = SA[1];
#pragma unroll
  for (int i = 0; i < 6; i++) {
    float nr = ar * ar - ai * ai, ni = 2.f * ar * ai;
    ar = nr; ai = ni;
  }
  float xr = 0.f, xi = 0.f;
  const float2* E = (const float2*)(ws + OFF_S5E);
  float2* XS = (float2*)(ws + OFF_S5XS);
#pragma unroll 4
  for (int c = 0; c < 32; c++) {
    size_t o = (size_t)((b * 16 + g) * 32 + c) * 64 + p;
    XS[o] = make_float2(xr, xi);
    float2 e = E[o];
    float nr = ar * xr - ai * xi + e.x, ni = ar * xi + ai * xr + e.y;
    xr = nr; xi = ni;
  }
}

__device__ void lru_local(const Params& P, int l, int item, char* smem) {
  char* ws = P.ws;
  const int hb = item & 3, c = (item >> 2) & 31, b = item >> 7;
  const int t0 = b * 2048 + c * 64;
  const int tid = otid(), j = tid & 63, tq = tid >> 6, ch = hb * 64 + j;
  float* xcT = (float*)smem;
  float* waL = xcT + 64 * 68;
  float* wxL = waL + 4096;
  float2* comp = (float2*)(wxL + 4096);
  const float* pb = (const float*)(ws + OFF_PBUF);
  __syncthreads();
  float xcv[16];
  {
    const float cw0 = P.in[I_CONVW][(l * 4 + 0) * 256 + ch], cw1 = P.in[I_CONVW][(l * 4 + 1) * 256 + ch],
                cw2 = P.in[I_CONVW][(l * 4 + 2) * 256 + ch], cw3 = P.in[I_CONVW][(l * 4 + 3) * 256 + ch];
    const float cb = P.in[I_CONVB][l * 256 + ch];
    const int tl0 = c * 64 + tq * 16;
    const float* xp = pb + (size_t)(t0 + tq * 16) * 2816 + 2304 + ch;
    float xm3 = (tl0 >= 3) ? xp[-3 * 2816] : 0.f;
    float xm2 = (tl0 >= 2) ? xp[-2 * 2816] : 0.f;
    float xm1 = (tl0 >= 1) ? xp[-1 * 2816] : 0.f;
#pragma unroll
    for (int i = 0; i < 16; i++) {
      float xt = xp[(size_t)i * 2816];
      xcv[i] = cw0 * xm3 + cw1 * xm2 + cw2 * xm1 + cw3 * xt + cb;
      xm3 = xm2; xm2 = xm1; xm1 = xt;
    }
#pragma unroll
    for (int q = 0; q < 4; q++)
      *(float4*)(xcT + j * 68 + tq * 16 + q * 4) = make_float4(xcv[q * 4], xcv[q * 4 + 1], xcv[q * 4 + 2], xcv[q * 4 + 3]);
  }
#pragma unroll 4
  for (int i = 0; i < 16; i++) {
    int idx = tid + i * NTHR;
    waL[idx] = P.in[I_WA][(size_t)(l * 4 + hb) * 4096 + idx];
    wxL[idx] = P.in[I_WX][(size_t)(l * 4 + hb) * 4096 + idx];
  }
  __syncthreads();
  float accA[16], accX[16];
#pragma unroll
  for (int i = 0; i < 16; i++) { accA[i] = 0.f; accX[i] = 0.f; }
#pragma unroll 2
  for (int i = 0; i < 64; i++) {
    float wa = waL[i * 64 + j], wx = wxL[i * 64 + j];
#pragma unroll
    for (int q = 0; q < 4; q++) {
      float4 xv = *(const float4*)(xcT + i * 68 + tq * 16 + q * 4);
      accA[q * 4 + 0] += xv.x * wa; accA[q * 4 + 1] += xv.y * wa; accA[q * 4 + 2] += xv.z * wa; accA[q * 4 + 3] += xv.w * wa;
      accX[q * 4 + 0] += xv.x * wx; accX[q * 4 + 1] += xv.y * wx; accX[q * 4 + 2] += xv.z * wx; accX[q * 4 + 3] += xv.w * wx;
    }
  }
  const float ba = P.in[I_BA][l * 256 + ch], bx = P.in[I_BX][l * 256 + ch];
  const float sp = log1pf(expf(-P.in[I_LAM][l * 256 + ch]));
  float av[16], bt[16];
  float Pq = 1.f, Hq = 0.f;
#pragma unroll
  for (int i = 0; i < 16; i++) {
    float r = sigmoidf_(accA[i] + ba), ig = sigmoidf_(accX[i] + bx);
    float la = -8.f * r * sp;
    av[i] = expf(la);
    bt[i] = sqrtf(-expm1f(2.f * la)) * (ig * xcv[i]);
    Hq = av[i] * Hq + bt[i];
    Pq *= av[i];
  }
  comp[tq * 64 + j] = make_float2(Pq, Hq);
  __syncthreads();
  float Pin = 1.f, Hin = 0.f;
#pragma unroll
  for (int q = 0; q < 3; q++) {
    if (q < tq) {
      float2 cq2 = comp[q * 64 + j];
      Hin = cq2.x * Hin + cq2.y;
      Pin *= cq2.x;
    }
  }
  float* HL = (float*)(ws + OFF_HLOC);
  float* PC = (float*)(ws + OFF_PCUM);
#pragma unroll
  for (int i = 0; i < 16; i++) {
    Hin = av[i] * Hin + bt[i];
    Pin *= av[i];
    size_t o = (size_t)(t0 + tq * 16 + i) * 256 + ch;
    HL[o] = Hin;
    PC[o] = Pin;
  }
}

__device__ void lru_carry(const Params& P, int item) {
  char* ws = P.ws;
  const int idx = item * NTHR + otid(), ch = idx & 255, b = idx >> 8;
  const float* HL = (const float*)(ws + OFF_HLOC);
  const float* PC = (const float*)(ws + OFF_PCUM);
  float* HS = (float*)(ws + OFF_HST);
  float H = 0.f;
#pragma unroll 4
  for (int c = 0; c < 32; c++) {
    HS[(b * 32 + c) * 256 + ch] = H;
    size_t o = (size_t)(b * 2048 + c * 64 + 63) * 256 + ch;
    H = PC[o] * H + HL[o];
  }
}

__device__ void lru_final(const Params& P, int l, int item) {
  char* ws = P.ws;
  const int lane = otid() & 63, w = otid() >> 6;
  const float* HL = (const float*)(ws + OFF_HLOC);
  const float* PC = (const float*)(ws + OFF_PCUM);
  const float* HS = (const float*)(ws + OFF_HST);
  const float* pb = (const float*)(ws + OFF_PBUF);
  u16* YB = (u16*)(ws + OFF_YBUF);
  float* SS = (float*)(ws + OFF_SSQ) + (size_t)l * NTOK * 4;
  for (int i = 0; i < 16; i++) {
    int t = item * 64 + w * 16 + i;
    int b = t >> 11, c = (t & 2047) >> 6;
    float4 hl = *(const float4*)(HL + (size_t)t * 256 + lane * 4);
    float4 pc = *(const float4*)(PC + (size_t)t * 256 + lane * 4);
    float4 hs = *(const float4*)(HS + (b * 32 + c) * 256 + lane * 4);
    float4 z = *(const float4*)(pb + (size_t)t * 2816 + 2560 + lane * 4);
    float y0 = (hl.x + pc.x * hs.x) * geluf_(z.x);
    float y1 = (hl.y + pc.y * hs.y) * geluf_(z.y);
    float y2 = (hl.z + pc.z * hs.z) * geluf_(z.z);
    float y3 = (hl.w + pc.w * hs.w) * geluf_(z.w);
    uint2 o;
    o.x = pack2(y0, y1);
    o.y = pack2(y2, y3);
    *(uint2*)(YB + (size_t)t * 1024 + 768 + lane * 4) = o;
    float s = wave_sum(y0 * y0 + y1 * y1 + y2 * y2 + y3 * y3);
    if (lane == 0) SS[t * 4 + 2] = s;
  }
}

__device__ void phase_glu(const Params& P, int l, char* smem) {
  char* ws = P.ws;
  const u16* ZB = (const u16*)(ws + OFF_ZBUF);
  const u16* W = (const u16*)(ws + OFF_WGT) + (size_t)l * 65536;
  u16* YB = (u16*)(ws + OFF_YBUF);
  float* SS = (float*)(ws + OFF_SSQ) + (size_t)l * NTOK * 4;
  const float* bg = P.in[I_S5BGLU] + l * 256;
  const int lane = otid() & 63, wid = otid() >> 6, fr = lane & 15, fq = lane >> 4, wr = wid >> 1, wc = wid & 1;
  for (int tile = blockIdx.x; tile < 256; tile += gridDim.x) {
    int mt = tile >> 1, nt = tile & 1;
    gemm_tile<128>(ZB + (size_t)mt * 128 * 256, 256, W + (size_t)nt * 128 * 256, 256, 256, smem, NoHook(),
                   [&](f32x4(&acc)[4][4]) {
#pragma unroll
                     for (int m = 0; m < 4; m++)
#pragma unroll
                       for (int j = 0; j < 4; j++) {
                         int t = mt * 128 + wr * 64 + m * 16 + fq * 4 + j;
                         float s = 0.f;
#pragma unroll
                         for (int n = 0; n < 4; n++) {
                           int col = nt * 128 + wc * 64 + n * 16 + fr;
                           float z = bf2f(ZB[(size_t)t * 256 + col]);
                           float y = z * sigmoidf_(acc[m][n][j] + bg[col]);
                           YB[(size_t)t * 1024 + 512 + col] = f2bf(y);
                           s += y * y;
                         }
                         s += __shfl_xor(s, 1);
                         s += __shfl_xor(s, 2);
                         s += __shfl_xor(s, 4);
                         s += __shfl_xor(s, 8);
                         if (fr == 0) atomicAdd(&SS[t * 4 + 1], s);
                       }
                   });
  }
}

__device__ void phase_gemm_out(const Params& P, int l, char* smem) {
  char* ws = P.ws;
  const u16* YB = (const u16*)(ws + OFF_YBUF);
  const u16* W = (const u16*)(ws + OFF_WOUTT) + (size_t)l * 1048576;
  const float* SS = (const float*)(ws + OFF_SSQ) + (size_t)l * NTOK * 4;
  const float* xin = (l == 0) ? P.in[I_X] : (const float*)(ws + OFF_XRES);
  float* XR = (float*)(ws + OFF_XRES);
  const float* modl = (const float*)(ws + OFF_MOD) + (size_t)l * 8 * 6144;
  const int lane = otid() & 63, wid = otid() >> 6, fr = lane & 15, fq = lane >> 4, wr = wid >> 1, wc = wid & 1;
  for (int tile = blockIdx.x; tile < 1024; tile += gridDim.x) {
    int mt = tile >> 3, nt = tile & 7;
    const int rbase = mt * 128 + wr * 64 + fq * 4;
    gemm_tile<128>(
        YB + (size_t)mt * 128 * 1024, 1024, W + (size_t)nt * 128 * 1024, 1024, 1024, smem,
        [&](int kt, f32x4(&acc)[4][4]) {
          if (kt == 7 || kt == 11 || kt == 15) {
#pragma unroll
            for (int m = 0; m < 4; m++)
#pragma unroll
              for (int j = 0; j < 4; j++) {
                const float* s = SS + (size_t)(rbase + m * 16 + j) * 4;
                float ra = rsqrtf(s[0] * (1.f / 512.f) + EPSF);
                float rb = rsqrtf(s[1] * (1.f / 256.f) + EPSF);
                float rc = rsqrtf(s[2] * (1.f / 256.f) + EPSF);
                float f = (kt == 7) ? (ra / rb) : ((kt == 11) ? (rb / rc) : rc);
#pragma unroll
                for (int n = 0; n < 4; n++) acc[m][n][j] *= f;
              }
          }
        },
        [&](f32x4(&acc)[4][4]) {
          const float* gt = modl + (size_t)(mt >> 4) * 6144 + 2048 + nt * 128 + wc * 64;
#pragma unroll
          for (int m = 0; m < 4; m++)
#pragma unroll
            for (int n = 0; n < 4; n++)
#pragma unroll
              for (int j = 0; j < 4; j++) {
                size_t o = (size_t)(rbase + m * 16 + j) * 1024 + nt * 128 + wc * 64 + n * 16 + fr;
                XR[o] = xin[o] + gt[n * 16 + fr] * acc[m][n][j];
              }
        });
  }
}

__device__ void phase_gemm_q(const Params& P, int l, char* smem) {
  char* ws = P.ws;
  const u16* HB = (const u16*)(ws + OFF_HBUF);
  const u16* W = (const u16*)(ws + OFF_WQT) + (size_t)l * 2048 * 1024;
  u16* QB = (u16*)(ws + OFF_QBUF);
  const int lane = otid() & 63, wid = otid() >> 6, fr = lane & 15, fq = lane >> 4, wr = wid >> 1, wc = wid & 1;
  for (int tile = blockIdx.x; tile < 2048; tile += gridDim.x) {
    int mt = tile >> 4, nt = tile & 15;
    gemm_tile<128>(HB + (size_t)mt * 128 * 1024, 1024, W + (size_t)nt * 128 * 1024, 1024, 1024, smem, NoHook(),
                   [&](f32x4(&acc)[4][4]) {
#pragma unroll
                     for (int m = 0; m < 4; m++)
#pragma unroll
                       for (int n = 0; n < 4; n++)
#pragma unroll
                         for (int j = 0; j < 4; j++)
                           QB[(size_t)(mt * 128 + wr * 64 + m * 16 + fq * 4 + j) * 2048 + nt * 128 + wc * 64 + n * 16 + fr] =
                               f2bf(acc[m][n][j]);
                   });
  }
}

__device__ void phase_scores(const Params& P, int l, char* smem) {
  char* ws = P.ws;
  const u16* QB = (const u16*)(ws + OFF_QBUF);
  const u16* KB = (const u16*)(ws + OFF_KEYS) + (size_t)l * 2 * 16384;
  float* STP = (float*)(ws + OFF_STOP);
  const int tid = otid(), lane = tid & 63, wid = tid >> 6, fr = lane & 15, fq = lane >> 4, wr = wid >> 1, wc = wid & 1;
  float* tile = (float*)(smem + 27648);
  for (int it = blockIdx.x; it < 4096; it += gridDim.x) {
    int p = it & 1, R0 = (it >> 1) * 64;
    gemm_tile<64>(QB + (size_t)R0 * 256 + p * 128, 256, KB + (size_t)p * 16384, 128, 128, smem, NoHook(),
                  [&](f32x4(&acc)[2][4]) {
#pragma unroll
                    for (int m = 0; m < 2; m++)
#pragma unroll
                      for (int n = 0; n < 4; n++)
#pragma unroll
                        for (int j = 0; j < 4; j++)
                          tile[(wr * 32 + m * 16 + fq * 4 + j) * 129 + wc * 64 + n * 16 + fr] = acc[m][n][j];
                  });
    __syncthreads();
    if (tid < 64) {
      float top[16];
#pragma unroll
      for (int i = 0; i < 16; i++) top[i] = -3.0e38f;
      for (int k = 0; k < 128; k++) {
        float v = __uint_as_float((__float_as_uint(tile[tid * 129 + k]) & ~0x7Fu) | (unsigned)k);
#pragma unroll
        for (int i = 0; i < 16; i++) {
          float hi = fmaxf(top[i], v);
          v = fminf(top[i], v);
          top[i] = hi;
        }
      }
      float4* o = (float4*)(STP + ((size_t)(R0 + tid) * 2 + p) * 16);
      o[0] = make_float4(top[0], top[1], top[2], top[3]);
      o[1] = make_float4(top[4], top[5], top[6], top[7]);
      o[2] = make_float4(top[8], top[9], top[10], top[11]);
      o[3] = make_float4(top[12], top[13], top[14], top[15]);
    }
  }
}

__device__ void phase_peer(const Params& P, int l, char* smem) {
  char* ws = P.ws;
  const int tid = otid(), lane = tid & 63, w = tid >> 6;
  int* EX = (int*)smem;
  float* GT = (float*)(smem + 16384);
  const float* STP = (const float*)(ws + OFF_STOP);
  u16* HB = (u16*)(ws + OFF_HBUF);
  float* XR = (float*)(ws + OFF_XRES);
  const u16* UB = (const u16*)(ws + OFF_UB) + (size_t)l * 16384 * 1024;
  const u16* VB = (const u16*)(ws + OFF_VB) + (size_t)l * 16384 * 1024;
  const float* modl = (const float*)(ws + OFF_MOD) + (size_t)l * 8 * 6144;
  const float* modn = (const float*)(ws + OFF_MOD) + (size_t)(l + 1) * 8 * 6144;
  for (int item = blockIdx.x; item < 512; item += gridDim.x) {
    const int tok0 = item * 32;
    __syncthreads();
    {
      const int tt = tid >> 3, h = tid & 7, t = tok0 + tt;
      const float* s1p = STP + ((size_t)(t * 8 + h) * 2 + 0) * 16;
      const float* s2p = s1p + 16;
      float s1[16], s2[16];
#pragma unroll
      for (int i = 0; i < 4; i++) {
        float4 a = ((const float4*)s1p)[i], bq = ((const float4*)s2p)[i];
        s1[i * 4] = a.x; s1[i * 4 + 1] = a.y; s1[i * 4 + 2] = a.z; s1[i * 4 + 3] = a.w;
        s2[i * 4] = bq.x; s2[i * 4 + 1] = bq.y; s2[i * 4 + 2] = bq.z; s2[i * 4 + 3] = bq.w;
      }
#pragma unroll
      for (int i = 0; i < 16; i++) {
        s1[i] = __uint_as_float(__float_as_uint(s1[i]) & ~0x7Fu);
        s2[i] = __uint_as_float(__float_as_uint(s2[i]) & ~0x7Fu);
      }
      float top[16];
#pragma unroll
      for (int i = 0; i < 16; i++) top[i] = -3.0e38f;
#pragma unroll
      for (int i = 0; i < 16; i++)
#pragma unroll
        for (int j = 0; j < 16; j++)
          if ((i + 1) * (j + 1) <= 16) {
            float v = __uint_as_float((__float_as_uint(s1[i] + s2[j]) & ~0xFFu) | (unsigned)(i * 16 + j));
#pragma unroll
            for (int q = 0; q < 16; q++) {
              float hi = fmaxf(top[q], v);
              v = fminf(top[q], v);
              top[q] = hi;
            }
          }
      const float mx = __uint_as_float(__float_as_uint(top[0]) & ~0xFFu);
      float ev[16], sum = 0.f;
#pragma unroll
      for (int k = 0; k < 16; k++) {
        unsigned bits = __float_as_uint(top[k]);
        int code = bits & 0xFF;
        int i1 = __float_as_uint(s1p[code >> 4]) & 0x7F;
        int i2 = __float_as_uint(s2p[code & 15]) & 0x7F;
        EX[(tt * 8 + h) * 16 + k] = i1 * 128 + i2;
        ev[k] = __expf(__uint_as_float(bits & ~0xFFu) - mx);
        sum += ev[k];
      }
      const float inv = 1.f / sum;
#pragma unroll
      for (int k = 0; k < 16; k++) GT[(tt * 8 + h) * 16 + k] = ev[k] * inv;
    }
    __syncthreads();
    for (int q = 0; q < 8; q++) {
      const int tt = w * 8 + q, t = tok0 + tt;
      float hf[16];
      {
        const uint4* hp = (const uint4*)(HB + (size_t)t * 1024);
        uint4 hA = hp[lane], hB2 = hp[64 + lane];
        hf[0] = bflo(hA.x); hf[1] = bfhi(hA.x); hf[2] = bflo(hA.y); hf[3] = bfhi(hA.y);
        hf[4] = bflo(hA.z); hf[5] = bfhi(hA.z); hf[6] = bflo(hA.w); hf[7] = bfhi(hA.w);
        hf[8] = bflo(hB2.x); hf[9] = bfhi(hB2.x); hf[10] = bflo(hB2.y); hf[11] = bfhi(hB2.y);
        hf[12] = bflo(hB2.z); hf[13] = bfhi(hB2.z); hf[14] = bflo(hB2.w); hf[15] = bfhi(hB2.w);
      }
      float out[16];
#pragma unroll
      for (int i = 0; i < 16; i++) out[i] = 0.f;
      for (int hh = 0; hh < 16; hh++) {
        const int* ex = EX + tt * 128 + hh * 8;
        const float* gtp = GT + tt * 128 + hh * 8;
        uint4 ua[8], ubb[8], va[8], vb[8];
#pragma unroll
        for (int k = 0; k < 8; k++) {
          int e = __builtin_amdgcn_readfirstlane(ex[k]);
          const uint4* up = (const uint4*)(UB + (size_t)e * 1024);
          const uint4* vp = (const uint4*)(VB + (size_t)e * 1024);
          ua[k] = up[lane]; ubb[k] = up[64 + lane];
          va[k] = vp[lane]; vb[k] = vp[64 + lane];
        }
        float wk[8];
#pragma unroll
        for (int k = 0; k < 8; k++) {
          float dsum = hf[0] * bflo(ua[k].x) + hf[1] * bfhi(ua[k].x) + hf[2] * bflo(ua[k].y) + hf[3] * bfhi(ua[k].y) +
                       hf[4] * bflo(ua[k].z) + hf[5] * bfhi(ua[k].z) + hf[6] * bflo(ua[k].w) + hf[7] * bfhi(ua[k].w) +
                       hf[8] * bflo(ubb[k].x) + hf[9] * bfhi(ubb[k].x) + hf[10] * bflo(ubb[k].y) + hf[11] * bfhi(ubb[k].y) +
                       hf[12] * bflo(ubb[k].z) + hf[13] * bfhi(ubb[k].z) + hf[14] * bflo(ubb[k].w) + hf[15] * bfhi(ubb[k].w);
          dsum = wave_sum(dsum);
          wk[k] = gtp[k] * geluf_(dsum);
        }
#pragma unroll
        for (int k = 0; k < 8; k++) {
          out[0] += wk[k] * bflo(va[k].x); out[1] += wk[k] * bfhi(va[k].x);
          out[2] += wk[k] * bflo(va[k].y); out[3] += wk[k] * bfhi(va[k].y);
          out[4] += wk[k] * bflo(va[k].z); out[5] += wk[k] * bfhi(va[k].z);
          out[6] += wk[k] * bflo(va[k].w); out[7] += wk[k] * bfhi(va[k].w);
          out[8] += wk[k] * bflo(vb[k].x); out[9] += wk[k] * bfhi(vb[k].x);
          out[10] += wk[k] * bflo(vb[k].y); out[11] += wk[k] * bfhi(vb[k].y);
          out[12] += wk[k] * bflo(vb[k].z); out[13] += wk[k] * bfhi(vb[k].z);
          out[14] += wk[k] * bflo(vb[k].w); out[15] += wk[k] * bfhi(vb[k].w);
        }
      }
      const int b = t >> 11;
      float xn[16];
      float ss = 0.f;
#pragma unroll
      for (int hf2 = 0; hf2 < 2; hf2++) {
        const int col = hf2 * 512 + lane * 8;
        float4 x0 = *(const float4*)(XR + (size_t)t * 1024 + col), x1 = *(const float4*)(XR + (size_t)t * 1024 + col + 4);
        float4 g0 = *(const float4*)(modl + (size_t)b * 6144 + 5120 + col), g1 = *(const float4*)(modl + (size_t)b * 6144 + 5120 + col + 4);
        float* o = out + hf2 * 8;
        float* x = xn + hf2 * 8;
        x[0] = x0.x + g0.x * o[0]; x[1] = x0.y + g0.y * o[1]; x[2] = x0.z + g0.z * o[2]; x[3] = x0.w + g0.w * o[3];
        x[4] = x1.x + g1.x * o[4]; x[5] = x1.y + g1.y * o[5]; x[6] = x1.z + g1.z * o[6]; x[7] = x1.w + g1.w * o[7];
#pragma unroll
        for (int i = 0; i < 8; i++) ss += x[i] * x[i];
      }
      ss = wave_sum(ss);
      const float rstd = rsqrtf(ss * (1.f / 1024.f) + EPSF);
      if (l < 3) {
#pragma unroll
        for (int hf2 = 0; hf2 < 2; hf2++) {
          const int col = hf2 * 512 + lane * 8;
          float* x = xn + hf2 * 8;
          *(float4*)(XR + (size_t)t * 1024 + col) = make_float4(x[0], x[1], x[2], x[3]);
          *(float4*)(XR + (size_t)t * 1024 + col + 4) = make_float4(x[4], x[5], x[6], x[7]);
          const float* gm = P.in[I_GMIX] + (l + 1) * 1024 + col;
          const float* sc = modn + (size_t)b * 6144 + 1024 + col;
          const float* sh = modn + (size_t)b * 6144 + col;
          float hv[8];
#pragma unroll
          for (int i = 0; i < 8; i++) hv[i] = x[i] * rstd * gm[i] * (1.f + sc[i]) + sh[i];
          uint4 o;
          o.x = pack2(hv[0], hv[1]); o.y = pack2(hv[2], hv[3]); o.z = pack2(hv[4], hv[5]); o.w = pack2(hv[6], hv[7]);
          *(uint4*)(HB + (size_t)t * 1024 + col) = o;
        }
      } else {
#pragma unroll
        for (int hf2 = 0; hf2 < 2; hf2++) {
          const int col = hf2 * 512 + lane * 8;
          float* x = xn + hf2 * 8;
          const float* gf = P.in[I_GFINAL] + col;
          *(float4*)(P.out + (size_t)t * 1024 + col) = make_float4(x[0] * rstd * gf[0], x[1] * rstd * gf[1], x[2] * rstd * gf[2], x[3] * rstd * gf[3]);
          *(float4*)(P.out + (size_t)t * 1024 + col + 4) = make_float4(x[4] * rstd * gf[4], x[5] * rstd * gf[5], x[6] * rstd * gf[6], x[7] * rstd * gf[7]);
        }
      }
    }
  }
}

#ifndef MLM
#define MLM 7
#endif
__device__ void phase_mix_local(const Params& P, int l, char* smem) {
  for (int item = blockIdx.x; item < 3072; item += gridDim.x) {
    if (item < 1024) { if (MLM & 1) hgrn_local(P, l, item, smem); }
    else if (item < 2048) { if (MLM & 2) s5_pass<false>(P, l, item - 1024, smem); }
    else { if (MLM & 4) lru_local(P, l, item - 2048, smem); }
  }
}
__device__ void phase_mix_carry(const Params& P, int l) {
  for (int item = blockIdx.x; item < 2048 + 32 + 8; item += gridDim.x) {
    if (item < 2048) hgrn_carry(P, item);
    else if (item < 2080) s5_carry(P, l, item - 2048);
    else lru_carry(P, item - 2080);
  }
}
__device__ void phase_mix_final(const Params& P, int l, char* smem) {
  for (int item = blockIdx.x; item < 1024 + 1024 + 256; item += gridDim.x) {
    if (item < 1024) hgrn_final(P, l, item, smem);
    else if (item < 2048) s5_pass<true>(P, l, item - 1024, smem);
    else lru_final(P, l, item - 2048);
  }
}

#ifndef PHM
#define PHM 0xFFFF
#endif
#define PHON(k) ((PHM >> (k)) & 1)
__global__ void __launch_bounds__(NTHR, 2) mega_kernel(Params P) {
  __shared__ __attribute__((aligned(16))) char smem[65536];
  cg::grid_group grid = cg::this_grid();
  char* ws = P.ws;
  if (PHON(0)) phase_prep(P, smem);
  grid.sync();
  phase_norm(P.in[I_X], P.in[I_GMIX], (const float*)(ws + OFF_MOD), 0, 1024, (u16*)(ws + OFF_HBUF));
  grid.sync();
  for (int l = 0; l < 4; l++) {
    if (PHON(1)) phase_gemm_in(P, l, smem);
    grid.sync();
    if (PHON(2)) phase_mix_local(P, l, smem);
    grid.sync();
    if (PHON(3)) phase_mix_carry(P, l);
    grid.sync();
    if (PHON(4)) phase_mix_final(P, l, smem);
    grid.sync();
    if (PHON(5)) phase_glu(P, l, smem);
    grid.sync();
    if (PHON(6)) phase_gemm_out(P, l, smem);
    grid.sync();
    phase_norm((const float*)(ws + OFF_XRES), P.in[I_GFFN] + l * 1024, (const float*)(ws + OFF_MOD) + (size_t)l * 8 * 6144,
               3072, 4096, (u16*)(ws + OFF_HBUF));
    grid.sync();
    if (PHON(7)) phase_gemm_q(P, l, smem);
    grid.sync();
    if (PHON(8)) phase_scores(P, l, smem);
    grid.sync();
    if (PHON(9)) phase_peer(P, l, smem);
    grid.sync();
  }
}

extern "C" void kernel_launch(void* const* d_in, const int* in_sizes, int n_in, void* d_out, int out_size, void* d_ws,
                              size_t ws_size, hipStream_t stream) {
  static int grid_blocks = 0;
  if (!grid_blocks) {
    int dev = 0, cus = 0, per_cu = 0;
    hipGetDevice(&dev);
    hipDeviceGetAttribute(&cus, hipDeviceAttributeMultiprocessorCount, dev);
    hipOccupancyMaxActiveBlocksPerMultiprocessor(&per_cu, mega_kernel, NTHR, 0);
    if (per_cu < 1) per_cu = 1;
    if (per_cu > 2) per_cu = 2;
    grid_blocks = cus * per_cu;
  }
  if (ws_size < WS_TOTAL) fprintf(stderr, "workspace too small: %zu < %zu\n", ws_size, (size_t)WS_TOTAL);
  Params p{};
  for (int i = 0; i < 32; i++) p.in[i] = (const float*)d_in[i];
  p.out = (float*)d_out;
  p.ws = (char*)d_ws;
  void* args[] = {&p};
  hipError_t e = hipLaunchCooperativeKernel((void*)mega_kernel, dim3(grid_blocks), dim3(NTHR), args, 0, stream);
  if (e != hipSuccess) fprintf(stderr, "cooperative launch failed: %s (grid %d)\n", hipGetErrorString(e), grid_blocks);
}
```

```cpp
#define PEER_ALIGN 1
#include <hip/hip_runtime.h>
#include <hip/hip_cooperative_groups.h>
#include <cstdio>
namespace cg = cooperative_groups;

typedef unsigned short u16;
using bf16x8 = __attribute__((ext_vector_type(8))) short;
using f32x4 = __attribute__((ext_vector_type(4))) float;
using u32x4 = __attribute__((ext_vector_type(4))) unsigned;

#define NTOK 16384
#define EPSF 1e-6f
#define NTHR 256

constexpr size_t OFF_WINT = 0;
constexpr size_t OFF_WOUTT = OFF_WINT + 4ull * 2816 * 1024 * 2;
constexpr size_t OFF_WQT = OFF_WOUTT + 4ull * 1024 * 1024 * 2;
constexpr size_t OFF_WGT = OFF_WQT + 4ull * 2048 * 1024 * 2;
constexpr size_t OFF_KEYS = OFF_WGT + 4ull * 256 * 256 * 2;
constexpr size_t OFF_UB = OFF_KEYS + 4ull * 2 * 128 * 128 * 2;
constexpr size_t OFF_VB = OFF_UB + 134217728ull;
constexpr size_t OFF_MOD = OFF_VB + 134217728ull;
constexpr size_t OFF_LB = OFF_MOD + 786432;
constexpr size_t OFF_S5A = OFF_LB + 8192;
constexpr size_t OFF_S5BB = OFF_S5A + 32768;
constexpr size_t OFF_SSQ = OFF_S5BB + 524288;
constexpr size_t OFF_XRES = OFF_SSQ + 1048576;
constexpr size_t OFF_HBUF = OFF_XRES + 67108864;
constexpr size_t OFF_PBUF = OFF_HBUF + 33554432;
constexpr size_t OFF_YBUF = OFF_PBUF + 184549376;
constexpr size_t OFF_QBUF = OFF_YBUF + 33554432;
constexpr size_t OFF_STOP = OFF_QBUF + 67108864;
constexpr size_t OFF_OBUF = OFF_STOP + 16777216;
constexpr size_t OFF_QG = OFF_OBUF + 33554432;
constexpr size_t OFF_SLOC = OFF_QG + 16777216;
constexpr size_t OFF_ST = OFF_SLOC + 67108864;
constexpr size_t OFF_DEC = OFF_ST + 33554432;
constexpr size_t OFF_S5E = OFF_DEC + 524288;
constexpr size_t OFF_S5XS = OFF_S5E + 2097152;
constexpr size_t OFF_ZBUF = OFF_S5XS + 2097152;
constexpr size_t OFF_HLOC = OFF_ZBUF + 8388608;
constexpr size_t OFF_PCUM = OFF_HLOC + 16777216;
constexpr size_t OFF_HST = OFF_PCUM + 16777216;
constexpr size_t OFF_BAR = OFF_HST + 262144;
constexpr size_t OFF_SMALL = OFF_BAR + 16384;
constexpr int SM_GMIX = 0, SM_CRE = SM_GMIX + 4096, SM_CIM = SM_CRE + 65536, SM_S5D = SM_CIM + 65536, SM_BGLU = SM_S5D + 1024,
              SM_CONVW = SM_BGLU + 1024, SM_CONVB = SM_CONVW + 4096, SM_WA = SM_CONVB + 1024, SM_BA = SM_WA + 65536,
              SM_WX = SM_BA + 1024, SM_BX = SM_WX + 65536, SM_LAM = SM_BX + 1024, SM_GFFN = SM_LAM + 1024,
              SM_GFINAL = SM_GFFN + 4096, SM_TOTAL = SM_GFINAL + 1024;
constexpr size_t WS_TOTAL = OFF_SMALL + (size_t)SM_TOTAL * 4;
#define SMALLP(ws, off) ((const float*)((ws) + OFF_SMALL) + (off))
static_assert(WS_TOTAL <= (1ull << 30), "workspace too large");

struct Params {
  const float* in[32];
  float* out;
  char* ws;
};

enum { I_X = 0, I_C, I_WMOD, I_BMOD, I_GMIX, I_WIN, I_LBL, I_S5ARE, I_S5AIM, I_S5BRE, I_S5BIM, I_S5CRE, I_S5CIM,
       I_S5LOGDT, I_S5D, I_S5WGLU, I_S5BGLU, I_CONVW, I_CONVB, I_WA, I_BA, I_WX, I_BX, I_LAM, I_GBR, I_WOUT,
       I_GFFN, I_WQ, I_KEYS, I_U, I_V, I_GFINAL };

typedef __attribute__((address_space(1))) char gchar;
__device__ __forceinline__ gchar* ows(const Params& P) {
  gchar* w = (gchar*)P.ws;
  asm volatile("" : "+s"(w));
  return w;
}
__device__ __forceinline__ int otid() {
  int t = threadIdx.x;
  asm volatile("" : "+v"(t));
  return t;
}
__device__ __forceinline__ u16 f2bf(float f) {
  unsigned u = __float_as_uint(f);
  u += 0x7fffu + ((u >> 16) & 1u);
  return (u16)(u >> 16);
}
__device__ __forceinline__ float bf2f(u16 h) { return __uint_as_float(((unsigned)h) << 16); }
__device__ __forceinline__ unsigned pack2(float a, float b) { return (unsigned)f2bf(a) | ((unsigned)f2bf(b) << 16); }
__device__ __forceinline__ float bflo(unsigned w) { return __uint_as_float(w << 16); }
__device__ __forceinline__ float bfhi(unsigned w) { return __uint_as_float(w & 0xffff0000u); }
__device__ __forceinline__ float sigmoidf_(float x) { return 1.f / (1.f + __expf(-x)); }
__device__ __forceinline__ float siluf_(float x) { return x * sigmoidf_(x); }
__device__ __forceinline__ float geluf_(float x) {
  float u = 0.7978845608028654f * (x + 0.044715f * x * x * x);
  float t = __expf(2.f * u);
  float th = 1.f - 2.f / (t + 1.f);
  return 0.5f * x * (1.f + th);
}
template <int CTRL>
__device__ __forceinline__ float dpp_mov(float v) {
  return __int_as_float(__builtin_amdgcn_update_dpp(0, __float_as_int(v), CTRL, 0xF, 0xF, false));
}
__device__ __forceinline__ float row_sum16(float v) {
  v += dpp_mov<0xB1>(v);
  v += dpp_mov<0x4E>(v);
  v += dpp_mov<0x141>(v);
  v += dpp_mov<0x140>(v);
  return v;
}
__device__ __forceinline__ float rdlane(float v, int l) {
  return __int_as_float(__builtin_amdgcn_readlane(__float_as_int(v), l));
}
__device__ __forceinline__ float wave_sum(float v) {
  v = row_sum16(v);
  return (rdlane(v, 0) + rdlane(v, 16)) + (rdlane(v, 32) + rdlane(v, 48));
}


#define XB_TMO      128
#define XB_XCNT(j)  (256  + 64 * (j))
#define XB_XSUB(j)  (1280 + 64 * (j))
#define XB_XGEN(j)  (2304 + 64 * (j))
#define XB_TOP      3328
#define XB_TOPGEN   3392
#define XCD_BAR_WORDS 3456
#define XB_SPIN_CAP (1u << 18)
#define LAS __attribute__((address_space(3)))
__device__ __forceinline__ unsigned xb_ld(unsigned* p) { return __hip_atomic_load(p, __ATOMIC_RELAXED, __HIP_MEMORY_SCOPE_AGENT); }
__device__ __forceinline__ unsigned xb_add(unsigned* p, unsigned v) { return __hip_atomic_fetch_add(p, v, __ATOMIC_RELAXED, __HIP_MEMORY_SCOPE_AGENT); }
__device__ __forceinline__ unsigned xb_xcc_id() { return (unsigned)__builtin_amdgcn_s_getreg((3 << 11) | 20) & 0xFu; }
#define XB_SPIN(cond, bar) do { unsigned _sp = 0; while (cond) { __builtin_amdgcn_s_sleep(1); \
    if ((++_sp & 255u) == 0u) { if (xb_ld(&(bar)[XB_TMO])) break; if (_sp > XB_SPIN_CAP) { atomicAdd(&(bar)[XB_TMO], 1u); break; } } } } while (0)
struct XcdBarrier { unsigned* bar; unsigned x; volatile LAS unsigned* st; };
__device__ __forceinline__ XcdBarrier xcd_barrier_post(unsigned* bar, volatile LAS unsigned* st) {
  XcdBarrier b; b.bar = bar; b.x = xb_xcc_id(); b.st = st;
  if (threadIdx.x == 0) (void)xb_add(&bar[XB_XCNT(b.x)], 1u);
  return b;
}
__device__ __forceinline__ void xcd_barrier_complete(unsigned* bar, unsigned x, unsigned& nloc, unsigned& nx) {
  const unsigned G = gridDim.x * gridDim.y * gridDim.z;
  unsigned sum, cnt, mine, sp = 0u;
  for (;;) {
    sum = 0u; cnt = 0u; mine = 0u;
#pragma unroll
    for (unsigned j = 0; j < 16; ++j) { const unsigned c = xb_ld(&bar[XB_XCNT(j)]); sum += c; cnt += (c > 0u) ? 1u : 0u; mine = (j == x) ? c : mine; }
    if (sum == G) break;
    __builtin_amdgcn_s_sleep(1);
    if ((++sp & 255u) == 0u) { if (xb_ld(&bar[XB_TMO])) break; if (sp > XB_SPIN_CAP) { atomicAdd(&bar[XB_TMO], 1u); break; } }
  }
  nloc = mine > 0u ? mine : 1u; nx = cnt > 0u ? cnt : 1u;
}
__device__ __forceinline__ void xcd_barrier(const XcdBarrier& b) {
  asm volatile("s_waitcnt vmcnt(0)" ::: "memory");
  __syncthreads();
  if (threadIdx.x == 0) {
    unsigned* bar = b.bar;
    __builtin_amdgcn_s_waitcnt(0);
    unsigned nloc = b.st[0], nx = b.st[1];
    if (nloc == 0u) { xcd_barrier_complete(bar, b.x, nloc, nx); b.st[0] = nloc; b.st[1] = nx; }
    const unsigned old = xb_add(&bar[XB_XSUB(b.x)], 1u);
    const unsigned gen = old / nloc;
    if (old + 1u == (gen + 1u) * nloc) {
      __builtin_amdgcn_fence(__ATOMIC_RELEASE, "agent");
      asm volatile("s_waitcnt vmcnt(0)" ::: "memory");
      const unsigned og = xb_add(&bar[XB_TOP], 1u);
      const unsigned tg = og / nx;
      if (og + 1u == (tg + 1u) * nx) xb_add(&bar[XB_TOPGEN], 1u);
      else XB_SPIN(xb_ld(&bar[XB_TOPGEN]) == tg, bar);
      __builtin_amdgcn_fence(__ATOMIC_ACQUIRE, "agent");
      xb_add(&bar[XB_XGEN(b.x)], 1u);
      asm volatile("s_waitcnt vmcnt(0)" ::: "memory");
    } else {
      XB_SPIN(xb_ld(&bar[XB_XGEN(b.x)]) == gen, bar);
      __builtin_amdgcn_fence(__ATOMIC_ACQUIRE, "agent");
      asm volatile("s_waitcnt vmcnt(0)" ::: "memory");
    }
  }
  __syncthreads();
}

__device__ __forceinline__ void xcd_barrier_exec(const XcdBarrier& b) {
  __syncthreads();
  if (threadIdx.x == 0) {
    unsigned* bar = b.bar;
    unsigned nloc = b.st[0], nx = b.st[1];
    if (nloc == 0u) { xcd_barrier_complete(bar, b.x, nloc, nx); b.st[0] = nloc; b.st[1] = nx; }
    const unsigned old = xb_add(&bar[XB_XSUB(b.x)], 1u);
    const unsigned gen = old / nloc;
    if (old + 1u == (gen + 1u) * nloc) {
      const unsigned og = xb_add(&bar[XB_TOP], 1u);
      const unsigned tg = og / nx;
      if (og + 1u == (tg + 1u) * nx) xb_add(&bar[XB_TOPGEN], 1u);
      else XB_SPIN(xb_ld(&bar[XB_TOPGEN]) == tg, bar);
      xb_add(&bar[XB_XGEN(b.x)], 1u);
    } else {
      XB_SPIN(xb_ld(&bar[XB_XGEN(b.x)]) == gen, bar);
    }
  }
  __syncthreads();
}

template <int BM, class KH, class EP>
__device__ __forceinline__ void gemm_tile(const u16* __restrict__ A, int lda, const u16* __restrict__ Bt, int ldb,
                                          int K, char* smem, KH&& kh, EP&& ep) {
  constexpr int MT = BM / 32;
  constexpr int NA = BM * 8 / NTHR;
  u16* As = (u16*)smem;
  u16* Bs = As + BM * 72;
  const int tid = otid(), lane = tid & 63, wid = tid >> 6, fr = lane & 15, fq = lane >> 4, wr = wid >> 1,
            wc = wid & 1;
  u32x4 ra0[NA], rb0[4], ra1[NA], rb1[4];
  f32x4 acc[MT][4];
#pragma unroll
  for (int m = 0; m < MT; m++)
#pragma unroll
    for (int n = 0; n < 4; n++) acc[m][n] = f32x4{0.f, 0.f, 0.f, 0.f};
  const int nk = K >> 6;
#define GT_LOAD(RA, RB, K0)                                                        \
  {                                                                                \
    _Pragma("unroll") for (int i = 0; i < NA; i++) {                               \
      int q = tid + i * NTHR, r = q >> 3, kc = q & 7;                              \
      RA[i] = *(const u32x4*)(A + (size_t)r * lda + (K0) + kc * 8);                \
    }                                                                              \
    _Pragma("unroll") for (int i = 0; i < 4; i++) {                                \
      int q = tid + i * NTHR, r = q >> 3, kc = q & 7;                              \
      RB[i] = *(const u32x4*)(Bt + (size_t)r * ldb + (K0) + kc * 8);               \
    }                                                                              \
  }
#define GT_STEP(RA, RB, KT)                                                        \
  {                                                                                \
    __syncthreads();                                                               \
    _Pragma("unroll") for (int i = 0; i < NA; i++) {                               \
      int q = tid + i * NTHR, r = q >> 3, kc = q & 7;                              \
      *(u32x4*)(As + r * 72 + kc * 8) = RA[i];                                     \
    }                                                                              \
    _Pragma("unroll") for (int i = 0; i < 4; i++) {                                \
      int q = tid + i * NTHR, r = q >> 3, kc = q & 7;                              \
      *(u32x4*)(Bs + r * 72 + kc * 8) = RB[i];                                     \
    }                                                                              \
    __syncthreads();                                                               \
    if ((KT) + 2 < nk) GT_LOAD(RA, RB, ((KT) + 2) << 6)                            \
    _Pragma("unroll") for (int ks = 0; ks < 2; ks++) {                             \
      bf16x8 af[MT], bfr[4];                                                       \
      _Pragma("unroll") for (int m = 0; m < MT; m++)                               \
        af[m] = *(const bf16x8*)(As + (wr * (BM / 2) + m * 16 + fr) * 72 + ks * 32 + fq * 8); \
      _Pragma("unroll") for (int n = 0; n < 4; n++)                                \
        bfr[n] = *(const bf16x8*)(Bs + (wc * 64 + n * 16 + fr) * 72 + ks * 32 + fq * 8);      \
      _Pragma("unroll") for (int m = 0; m < MT; m++)                               \
        _Pragma("unroll") for (int n = 0; n < 4; n++)                              \
          acc[m][n] = __builtin_amdgcn_mfma_f32_16x16x32_bf16(af[m], bfr[n], acc[m][n], 0, 0, 0); \
    }                                                                              \
    kh((KT), acc);                                                                 \
  }
  GT_LOAD(ra0, rb0, 0)
  if (nk > 1) GT_LOAD(ra1, rb1, 64)
  for (int kt = 0; kt < nk; kt += 2) {
    GT_STEP(ra0, rb0, kt)
    if (kt + 1 < nk) GT_STEP(ra1, rb1, kt + 1)
  }
#undef GT_LOAD
#undef GT_STEP
  ep(acc);
}

template <class KH, class EP>
__device__ __forceinline__ void gemm_tile256(const u16* __restrict__ A, int lda, const u16* __restrict__ Bt, int ldb,
                                             int K, char* smem, KH&& kh, EP&& ep) {
  u16* As = (u16*)smem;
  u16* Bs = As + 256 * 72;
  const int tid = otid(), lane = tid & 63, wid = tid >> 6, fr = lane & 15, fq = lane >> 4, wr = wid >> 1,
            wc = wid & 1;
  u32x4 ra[8], rb[4];
  f32x4 acc[8][4];
#pragma unroll
  for (int m = 0; m < 8; m++)
#pragma unroll
    for (int n = 0; n < 4; n++) acc[m][n] = f32x4{0.f, 0.f, 0.f, 0.f};
  const int nk = K >> 6;
#pragma unroll
  for (int i = 0; i < 8; i++) {
    int q = tid + i * NTHR, r = q >> 3, kc = q & 7;
    ra[i] = *(const u32x4*)(A + (size_t)r * lda + kc * 8);
  }
#pragma unroll
  for (int i = 0; i < 4; i++) {
    int q = tid + i * NTHR, r = q >> 3, kc = q & 7;
    rb[i] = *(const u32x4*)(Bt + (size_t)r * ldb + kc * 8);
  }
  for (int kt = 0; kt < nk; kt++) {
    __syncthreads();
#pragma unroll
    for (int i = 0; i < 8; i++) {
      int q = tid + i * NTHR, r = q >> 3, kc = q & 7;
      *(u32x4*)(As + r * 72 + kc * 8) = ra[i];
    }
#pragma unroll
    for (int i = 0; i < 4; i++) {
      int q = tid + i * NTHR, r = q >> 3, kc = q & 7;
      *(u32x4*)(Bs + r * 72 + kc * 8) = rb[i];
    }
    __syncthreads();
    if (kt + 1 < nk) {
      const int k0 = (kt + 1) << 6;
#pragma unroll
      for (int i = 0; i < 8; i++) {
        int q = tid + i * NTHR, r = q >> 3, kc = q & 7;
        ra[i] = *(const u32x4*)(A + (size_t)r * lda + k0 + kc * 8);
      }
#pragma unroll
      for (int i = 0; i < 4; i++) {
        int q = tid + i * NTHR, r = q >> 3, kc = q & 7;
        rb[i] = *(const u32x4*)(Bt + (size_t)r * ldb + k0 + kc * 8);
      }
    }
#pragma unroll
    for (int ks = 0; ks < 2; ks++) {
      bf16x8 bfr[4];
#pragma unroll
      for (int n = 0; n < 4; n++) bfr[n] = *(const bf16x8*)(Bs + (wc * 64 + n * 16 + fr) * 72 + ks * 32 + fq * 8);
#pragma unroll
      for (int mh = 0; mh < 2; mh++) {
        bf16x8 af[4];
#pragma unroll
        for (int m = 0; m < 4; m++)
          af[m] = *(const bf16x8*)(As + (wr * 128 + (mh * 4 + m) * 16 + fr) * 72 + ks * 32 + fq * 8);
#pragma unroll
        for (int m = 0; m < 4; m++)
#pragma unroll
          for (int n = 0; n < 4; n++)
            acc[mh * 4 + m][n] = __builtin_amdgcn_mfma_f32_16x16x32_bf16(af[m], bfr[n], acc[mh * 4 + m][n], 0, 0, 0);
      }
    }
    kh(kt, acc);
  }
  ep(acc);
}

struct NoHook {
  template <class T>
  __device__ __forceinline__ void operator()(int, T&) const {}
};

__device__ __forceinline__ void transpose_tile(const float* __restrict__ src, int ld_src, u16* __restrict__ dst, int ld_dst, int k0,
                               int n0, const float* __restrict__ rowscale, char* smem) {
  float(*T)[65] = (float(*)[65])smem;
  const int tid = otid();
  __syncthreads();
#pragma unroll
  for (int i = 0; i < 16; i++) {
    int r = (tid >> 6) + 4 * i;
    float v = src[(size_t)(k0 + r) * ld_src + n0 + (tid & 63)];
    if (rowscale) v *= rowscale[k0 + r];
    T[r][tid & 63] = v;
  }
  __syncthreads();
#pragma unroll
  for (int i = 0; i < 16; i++) {
    int n = (tid >> 6) + 4 * i;
    dst[(size_t)(n0 + n) * ld_dst + k0 + (tid & 63)] = f2bf(T[tid & 63][n]);
  }
}

constexpr int NP_UV = 16384;
constexpr int NP_TIN = 2816;
constexpr int NP_TOUT = 1024;
constexpr int NP_TQ = 2048;
constexpr int NP_TG = 64;
constexpr int NP_MOD = 384;
constexpr int NP_LB = 1;
constexpr int NP_S5 = 4;
constexpr int NP_KEYS = 8;
constexpr int NP_SSQ = 16;
constexpr int NP_SM = 14;
constexpr int NP_TOTAL = NP_UV + NP_TIN + NP_TOUT + NP_TQ + NP_TG + NP_MOD + NP_LB + NP_S5 + NP_KEYS + NP_SSQ + NP_SM;

__device__ __forceinline__ void phase_prep(const Params& P, char* smem) {
  const int tid = otid();
  gchar* ws = ows(P);
  for (int item = blockIdx.x; item < NP_TOTAL; item += gridDim.x) {
    int idx = item;
    if (idx < NP_UV) {
      const float* src = (idx < 8192) ? P.in[I_U] : P.in[I_V];
      u16* dst = (u16*)(ws + ((idx < 8192) ? OFF_UB : OFF_VB));
      size_t base = (size_t)(idx & 8191) * 8192;
#pragma unroll
      for (int it = 0; it < 4; it++) {
        size_t e = base + (size_t)(it * NTHR + tid) * 8;
        float4 a = *(const float4*)(src + e);
        float4 b = *(const float4*)(src + e + 4);
        uint4 o;
        o.x = pack2(a.x, a.y); o.y = pack2(a.z, a.w); o.z = pack2(b.x, b.y); o.w = pack2(b.z, b.w);
        *(uint4*)(dst + e) = o;
      }
      continue;
    }
    idx -= NP_UV;
    if (idx < NP_TIN) {
      int l = idx / 704, r = idx % 704, kt = r / 44, nt = r % 44;
      transpose_tile(P.in[I_WIN] + (size_t)l * 1024 * 2816, 2816, (u16*)(ws + OFF_WINT) + (size_t)l * 2816 * 1024, 1024,
                     kt * 64, nt * 64, nullptr, smem);
      continue;
    }
    idx -= NP_TIN;
    if (idx < NP_TOUT) {
      int l = idx >> 8, r = idx & 255, kt = r >> 4, nt = r & 15;
      transpose_tile(P.in[I_WOUT] + (size_t)l * 1048576, 1024, (u16*)(ws + OFF_WOUTT) + (size_t)l * 1048576, 1024,
                     kt * 64, nt * 64, P.in[I_GBR] + l * 1024, smem);
      continue;
    }
    idx -= NP_TOUT;
    if (idx < NP_TQ) {
      int l = idx >> 9, r = idx & 511, kt = r >> 5, nt = r & 31;
      transpose_tile(P.in[I_WQ] + (size_t)l * 1024 * 2048, 2048, (u16*)(ws + OFF_WQT) + (size_t)l * 2048 * 1024, 1024,
                     kt * 64, nt * 64, nullptr, smem);
      continue;
    }
    idx -= NP_TQ;
    if (idx < NP_TG) {
      int l = idx >> 4, r = idx & 15, kt = r >> 2, nt = r & 3;
      transpose_tile(P.in[I_S5WGLU] + (size_t)l * 65536, 256, (u16*)(ws + OFF_WGT) + (size_t)l * 65536, 256, kt * 64,
                     nt * 64, nullptr, smem);
      continue;
    }
    idx -= NP_TG;
    if (idx < NP_MOD) {
      int l = idx / 96, n0 = (idx % 96) * 64;
      float* cs = (float*)smem;
      float* red = cs + 8192;
      __syncthreads();
      for (int i = tid; i < 8192; i += NTHR) cs[i] = siluf_(P.in[I_C][i]);
      __syncthreads();
      int j = tid & 63, kq = tid >> 6;
      float a[8];
#pragma unroll
      for (int b = 0; b < 8; b++) a[b] = 0.f;
      const float* w = P.in[I_WMOD] + (size_t)l * 1024 * 6144 + n0 + j;
      for (int k0 = kq * 256; k0 < kq * 256 + 256; k0 += 16) {
        float wv[16];
#pragma unroll
        for (int u = 0; u < 16; u++) wv[u] = w[(size_t)(k0 + u) * 6144];
#pragma unroll
        for (int u = 0; u < 16; u++)
#pragma unroll
          for (int b = 0; b < 8; b++) a[b] += cs[b * 1024 + k0 + u] * wv[u];
      }
#pragma unroll
      for (int b = 0; b < 8; b++) red[(kq * 8 + b) * 64 + j] = a[b];
      __syncthreads();
      for (int o = tid; o < 512; o += NTHR) {
        int b = o >> 6, jj = o & 63;
        float s = red[(0 * 8 + b) * 64 + jj] + red[(1 * 8 + b) * 64 + jj] + red[(2 * 8 + b) * 64 + jj] +
                  red[(3 * 8 + b) * 64 + jj];
        s += P.in[I_BMOD][l * 6144 + n0 + jj];
        ((float*)(ws + OFF_MOD))[(size_t)(l * 8 + b) * 6144 + n0 + jj] = s;
      }
      continue;
    }
    idx -= NP_MOD;
    if (idx < NP_LB) {
      float* LB = (float*)(ws + OFF_LB);
      for (int ch = tid; ch < 512; ch += NTHR) {
        float v0 = P.in[I_LBL][ch], v1 = P.in[I_LBL][512 + ch], v2 = P.in[I_LBL][1024 + ch], v3 = P.in[I_LBL][1536 + ch];
        float m = fmaxf(fmaxf(v0, v1), fmaxf(v2, v3));
        float e0 = expf(v0 - m), e1 = expf(v1 - m), e2 = expf(v2 - m), e3 = expf(v3 - m);
        float inv = 1.f / (e0 + e1 + e2 + e3);
        LB[ch] = 0.f;
        LB[512 + ch] = e1 * inv;
        LB[1024 + ch] = (e1 + e2) * inv;
        LB[1536 + ch] = (e1 + e2 + e3) * inv;
      }
      continue;
    }
    idx -= NP_LB;
    if (idx < NP_S5) {
      int l = idx;
      float* SA = (float*)(ws + OFF_S5A);
      float* SB = (float*)(ws + OFF_S5BB);
      for (int gp = tid; gp < 1024; gp += NTHR) {
        int g = gp >> 6;
        float lre = fminf(P.in[I_S5ARE][l * 1024 + gp], -1e-4f);
        float lim = P.in[I_S5AIM][l * 1024 + gp];
        float dt = expf(P.in[I_S5LOGDT][l * 16 + g]);
        float mag = expf(lre * dt);
        float abr = mag * cosf(lim * dt), abi = mag * sinf(lim * dt);
        float den = lre * lre + lim * lim;
        float nr = abr - 1.f;
        float zr = (nr * lre + abi * lim) / den;
        float zi = (abi * lre - nr * lim) / den;
        SA[(l * 1024 + gp) * 2 + 0] = abr;
        SA[(l * 1024 + gp) * 2 + 1] = abi;
        const float* br = P.in[I_S5BRE] + (size_t)(l * 1024 + gp) * 16;
        const float* bi = P.in[I_S5BIM] + (size_t)(l * 1024 + gp) * 16;
        float* o = SB + (size_t)(l * 1024 + gp) * 32;
#pragma unroll
        for (int c = 0; c < 16; c++) {
          o[c] = zr * br[c] - zi * bi[c];
          o[16 + c] = zr * bi[c] + zi * br[c];
        }
      }
      continue;
    }
    idx -= NP_S5;
    if (idx < NP_KEYS) {
      u16* KB = (u16*)(ws + OFF_KEYS);
#pragma unroll 16
      for (int i = 0; i < 64; i++) {
        int e = idx * 16384 + i * NTHR + tid;
        KB[e] = f2bf(P.in[I_KEYS][e]);
      }
      continue;
    }
    idx -= NP_KEYS;
    if (idx < NP_SSQ) {
      float* SS = (float*)(ws + OFF_SSQ);
      for (int i = 0; i < 64; i++) SS[idx * 16384 + i * NTHR + tid] = 0.f;
      continue;
    }
    idx -= NP_SSQ;
    {
      const float* src; int off, n;
      switch (idx) {
        case 0: src = P.in[I_GMIX]; off = SM_GMIX; n = 4096; break;
        case 1: src = P.in[I_S5CRE]; off = SM_CRE; n = 65536; break;
        case 2: src = P.in[I_S5CIM]; off = SM_CIM; n = 65536; break;
        case 3: src = P.in[I_S5D]; off = SM_S5D; n = 1024; break;
        case 4: src = P.in[I_S5BGLU]; off = SM_BGLU; n = 1024; break;
        case 5: src = P.in[I_CONVW]; off = SM_CONVW; n = 4096; break;
        case 6: src = P.in[I_CONVB]; off = SM_CONVB; n = 1024; break;
        case 7: src = P.in[I_WA]; off = SM_WA; n = 65536; break;
        case 8: src = P.in[I_BA]; off = SM_BA; n = 1024; break;
        case 9: src = P.in[I_WX]; off = SM_WX; n = 65536; break;
        case 10: src = P.in[I_BX]; off = SM_BX; n = 1024; break;
        case 11: src = P.in[I_LAM]; off = SM_LAM; n = 1024; break;
        case 12: src = P.in[I_GFFN]; off = SM_GFFN; n = 4096; break;
        default: src = P.in[I_GFINAL]; off = SM_GFINAL; n = 1024; break;
      }
      float* dst = (float*)(ws + OFF_SMALL) + off;
      for (int i0 = tid; i0 < n; i0 += NTHR * 16) {
        float tmp[16];
#pragma unroll
        for (int u = 0; u < 16; u++) tmp[u] = (i0 + u * NTHR < n) ? src[i0 + u * NTHR] : 0.f;
#pragma unroll
        for (int u = 0; u < 16; u++)
          if (i0 + u * NTHR < n) dst[i0 + u * NTHR] = tmp[u];
      }
    }
  }
}

__device__ __forceinline__ void phase_norm(const float* __restrict__ xsrc, const float* __restrict__ g, const float* __restrict__ modl,
                           int sh_off, int sc_off, u16* __restrict__ hb) {
  const int lane = otid() & 63;
  const int wave = (blockIdx.x * NTHR + otid()) >> 6, nw = gridDim.x * 4;
  for (int t = wave; t < NTOK; t += nw) {
    const float4* xr = (const float4*)(xsrc + (size_t)t * 1024);
    float4 v[4];
    float ss = 0.f;
#pragma unroll
    for (int i = 0; i < 4; i++) {
      v[i] = xr[lane + 64 * i];
      ss += v[i].x * v[i].x + v[i].y * v[i].y + v[i].z * v[i].z + v[i].w * v[i].w;
    }
    ss = wave_sum(ss);
    float rstd = rsqrtf(ss * (1.f / 1024.f) + EPSF);
    const float* mb = modl + (size_t)(t >> 11) * 6144;
#pragma unroll
    for (int i = 0; i < 4; i++) {
      int col = (lane + 64 * i) * 4;
      float4 g4 = *(const float4*)(g + col);
      float4 sc = *(const float4*)(mb + sc_off + col);
      float4 sh = *(const float4*)(mb + sh_off + col);
      float h0 = v[i].x * rstd * g4.x * (1.f + sc.x) + sh.x;
      float h1 = v[i].y * rstd * g4.y * (1.f + sc.y) + sh.y;
      float h2 = v[i].z * rstd * g4.z * (1.f + sc.z) + sh.z;
      float h3 = v[i].w * rstd * g4.w * (1.f + sc.w) + sh.w;
      uint2 o;
      o.x = pack2(h0, h1);
      o.y = pack2(h2, h3);
      *(uint2*)(hb + (size_t)t * 1024 + col) = o;
    }
  }
}


#define XB_RANK(j) (3520 + 32 * (j))
__device__ __forceinline__ bool xcd_tile(int i, int NT, int n_tiles_total, char* smem, int& mt, int& nt, bool& more) {
  const volatile LAS unsigned* st = (const volatile LAS unsigned*)(smem + 65520);
  const unsigned nloc = st[0], nx = st[1], rank = st[2], xcc = st[3];
  if (nloc == 64u && nx == 8u && xcc < 8u && rank < 64u && gridDim.x == 512u) {
    mt = (int)(xcc * 8u + (rank >> 3));
    nt = i * 8 + (int)(rank & 7u);
    more = (i + 1) * 8 < NT;
    return nt < NT;
  }
  const int tile = blockIdx.x + i * gridDim.x;
  mt = tile / NT;
  nt = tile % NT;
  more = tile + (int)gridDim.x < n_tiles_total;
  return tile < n_tiles_total;
}
#define XCD_TILE_LOOP(NT, NTILES) \
  bool more_ = true;              \
  for (int i_ = 0; more_; i_++)

__device__ __forceinline__ void phase_gemm_in(const Params& P, int l, char* smem) {
  gchar* ws = ows(P);
  const u16* HB = (const u16*)(ws + OFF_HBUF);
  const u16* W = (const u16*)(ws + OFF_WINT) + (size_t)l * 2816 * 1024;
  float* PB = (float*)(ws + OFF_PBUF);
  const int lane = otid() & 63, wid = otid() >> 6, fr = lane & 15, fq = lane >> 4, wr = wid >> 1, wc = wid & 1;
  XCD_TILE_LOOP(22, 64 * 22) {
    int mt, nt;
    if (!xcd_tile(i_, 22, 64 * 22, smem, mt, nt, more_)) continue;
    float* out = PB + (size_t)(mt * 256) * 2816 + nt * 128;
    gemm_tile256(HB + (size_t)mt * 256 * 1024, 1024, W + (size_t)nt * 128 * 1024, 1024, 1024, smem, NoHook(),
                 [&](f32x4(&acc)[8][4]) {
                   const int t_ = otid(), l_ = t_ & 63, w_ = t_ >> 6, fr = l_ & 15, fq = l_ >> 4, wr = w_ >> 1, wc = w_ & 1;
#pragma unroll
                   for (int m = 0; m < 8; m++)
#pragma unroll
                     for (int j = 0; j < 4; j++) {
                       float* rp = out + (size_t)(wr * 128 + m * 16 + fq * 4 + j) * 2816 + wc * 64 + fr;
#pragma unroll
                       for (int n = 0; n < 4; n++) rp[n * 16] = acc[m][n][j];
                     }
                 });
  }
}

__device__ __forceinline__ void hgrn_local(const Params& P, int l, int item, char* smem) {
  gchar* ws = ows(P);
  const int c = item & 31, h = (item >> 5) & 3, b = item >> 7;
  const int t0 = b * 2048 + c * 64;
  int tid = otid();
  asm volatile("" : "+v"(tid));
  const int d = tid & 127, half = tid >> 7;
  const float* pb = (const float*)(ws + OFF_PBUF) + (size_t)t0 * 2816;
  const int lane = tid & 63, w = tid >> 6, fr = lane & 15, fq = lane >> 4;
  const float lbv = ((const float*)(ws + OFF_LB))[l * 512 + h * 128 + d];
  u16* Aq = (u16*)smem;
  u16* BI = Aq + 64 * 136;
  u16* Sc = BI + 64 * 136;
  u16* vT = Sc + 64 * 72;
  float* anc = (float*)(vT + 128 * 72);
  u16* kdT = (u16*)smem;
  __syncthreads();
  float bb[32];
  unsigned kkp[16];
  {
    float run = 0.f;
#pragma unroll
    for (int i = 0; i < 32; i++) {
      int t = half * 32 + i;
      float fp = pb[(size_t)t * 2816 + 512 + h * 128 + d];
      float f = lbv + (1.f - lbv) * sigmoidf_(fp);
      run += logf(f);
      bb[i] = run;
      if (i & 1) kkp[i >> 1] |= ((unsigned)f2bf(1.f - f)) << 16;
      else kkp[i >> 1] = (unsigned)f2bf(1.f - f);
      if ((i & 15) == 15) __builtin_amdgcn_sched_barrier(0);
    }
  }
  if (half == 0) {
    anc[d] = 0.f;
    anc[128 + d] = bb[15];
    anc[256 + d] = bb[31];
  }
  __syncthreads();
  if (half == 1) {
    float off = anc[256 + d];
#pragma unroll
    for (int i = 0; i < 32; i++) bb[i] += off;
    anc[384 + d] = bb[15];
    anc[512 + d] = bb[31];
  }
  __syncthreads();
  const float b31 = anc[256 + d], b63 = anc[512 + d];
  {
    u16* QG = (u16*)(ws + OFF_QG);
    const float a_lo = half ? b31 : 0.f;
    const float a_hi = bb[15];
#pragma unroll
    for (int i = 0; i < 32; i++) {
      int t = half * 32 + i;
      float q = pb[(size_t)t * 2816 + h * 128 + d];
      float qa = siluf_(q);
      float anchor = (i < 16) ? a_lo : a_hi;
      Aq[t * 136 + d] = f2bf(qa * __expf(bb[i] - anchor));
      QG[(size_t)(t0 + t) * 512 + h * 128 + d] = f2bf(qa * __expf(bb[i]));
      if ((i & 15) == 15) __builtin_amdgcn_sched_barrier(0);
    }
#pragma unroll
    for (int grp = 0; grp < 4; grp++) {
      float vv[8];
#pragma unroll
      for (int e = 0; e < 8; e++) vv[e] = pb[(size_t)(half * 32 + grp * 8 + e) * 2816 + 1024 + h * 128 + d];
      uint4 o;
      o.x = pack2(vv[0], vv[1]); o.y = pack2(vv[2], vv[3]); o.z = pack2(vv[4], vv[5]); o.w = pack2(vv[6], vv[7]);
      *(uint4*)(vT + d * 72 + half * 32 + grp * 8) = o;
      __builtin_amdgcn_sched_barrier(0);
    }
  }
  for (int I = 0; I < 4; I++) {
    __syncthreads();
    const float rI = anc[I * 128 + d];
#pragma unroll
    for (int i = 0; i < 32; i++) {
      int s = half * 32 + i;
      if (s < 16 * (I + 1)) BI[s * 136 + d] = f2bf(((i & 1) ? bfhi(kkp[i >> 1]) : bflo(kkp[i >> 1])) * __expf(rI - bb[i]));
    }
    __syncthreads();
    if (w <= I) {
      f32x4 acc = f32x4{0.f, 0.f, 0.f, 0.f};
#pragma unroll
      for (int ks = 0; ks < 4; ks++) {
        bf16x8 a = *(const bf16x8*)(Aq + (16 * I + fr) * 136 + ks * 32 + fq * 8);
        bf16x8 bq = *(const bf16x8*)(BI + (16 * w + fr) * 136 + ks * 32 + fq * 8);
        acc = __builtin_amdgcn_mfma_f32_16x16x32_bf16(a, bq, acc, 0, 0, 0);
      }
#pragma unroll
      for (int j = 0; j < 4; j++) {
        float val = acc[j];
        if (w == I && fr > fq * 4 + j) val = 0.f;
        Sc[(16 * I + fq * 4 + j) * 72 + 16 * w + fr] = f2bf(val);
      }
    } else {
#pragma unroll
      for (int j = 0; j < 4; j++) Sc[(16 * I + fq * 4 + j) * 72 + 16 * w + fr] = 0;
    }
  }
  __syncthreads();
#pragma unroll
  for (int grp = 0; grp < 4; grp++) {
    float vv[8];
#pragma unroll
    for (int e = 0; e < 8; e++) vv[e] = ((e & 1) ? bfhi(kkp[(grp * 8 + e) >> 1]) : bflo(kkp[(grp * 8 + e) >> 1])) * __expf(b63 - bb[grp * 8 + e]);
    uint4 o;
    o.x = pack2(vv[0], vv[1]); o.y = pack2(vv[2], vv[3]); o.z = pack2(vv[4], vv[5]); o.w = pack2(vv[6], vv[7]);
    *(uint4*)(kdT + d * 72 + half * 32 + grp * 8) = o;
  }
  {
    f32x4 oacc[4][2];
#pragma unroll
    for (int m = 0; m < 4; m++)
#pragma unroll
      for (int n = 0; n < 2; n++) oacc[m][n] = f32x4{0.f, 0.f, 0.f, 0.f};
#pragma unroll
    for (int ks = 0; ks < 2; ks++) {
      bf16x8 a[4], bq[2];
#pragma unroll
      for (int m = 0; m < 4; m++) a[m] = *(const bf16x8*)(Sc + (m * 16 + fr) * 72 + ks * 32 + fq * 8);
#pragma unroll
      for (int n = 0; n < 2; n++) bq[n] = *(const bf16x8*)(vT + ((2 * w + n) * 16 + fr) * 72 + ks * 32 + fq * 8);
#pragma unroll
      for (int m = 0; m < 4; m++)
#pragma unroll
        for (int n = 0; n < 2; n++) oacc[m][n] = __builtin_amdgcn_mfma_f32_16x16x32_bf16(a[m], bq[n], oacc[m][n], 0, 0, 0);
    }
    float* OB = (float*)(ws + OFF_OBUF);
#pragma unroll
    for (int m = 0; m < 4; m++)
#pragma unroll
      for (int n = 0; n < 2; n++)
#pragma unroll
        for (int j = 0; j < 4; j++)
          OB[(size_t)(t0 + m * 16 + fq * 4 + j) * 512 + h * 128 + (2 * w + n) * 16 + fr] = oacc[m][n][j];
  }
  __syncthreads();
  {
    f32x4 sacc[2][8];
#pragma unroll
    for (int m = 0; m < 2; m++)
#pragma unroll
      for (int n = 0; n < 8; n++) sacc[m][n] = f32x4{0.f, 0.f, 0.f, 0.f};
#pragma unroll
    for (int ks = 0; ks < 2; ks++) {
      bf16x8 a[2];
#pragma unroll
      for (int m = 0; m < 2; m++) a[m] = *(const bf16x8*)(vT + ((2 * w + m) * 16 + fr) * 72 + ks * 32 + fq * 8);
#pragma unroll
      for (int n = 0; n < 8; n++) {
        bf16x8 bq = *(const bf16x8*)(kdT + (n * 16 + fr) * 72 + ks * 32 + fq * 8);
#pragma unroll
        for (int m = 0; m < 2; m++) sacc[m][n] = __builtin_amdgcn_mfma_f32_16x16x32_bf16(a[m], bq, sacc[m][n], 0, 0, 0);
      }
    }
    float* SL = (float*)(ws + OFF_SLOC) + (size_t)((b * 4 + h) * 32 + c) * 16384;
#pragma unroll
    for (int m = 0; m < 2; m++)
#pragma unroll
      for (int n = 0; n < 8; n++)
#pragma unroll
        for (int j = 0; j < 4; j++) SL[((2 * w + m) * 16 + fq * 4 + j) * 128 + n * 16 + fr] = sacc[m][n][j];
    if (half == 1) ((float*)(ws + OFF_DEC))[((b * 4 + h) * 32 + c) * 128 + d] = __expf(b63);
  }
}

__device__ __forceinline__ void hgrn_carry(const Params& P, int item) {
  gchar* ws = ows(P);
  const int bh = item >> 6, e = (item & 63) * 256 + otid(), d = e & 127;
  const float* SL = (const float*)(ws + OFF_SLOC);
  const float* DC = (const float*)(ws + OFF_DEC);
  u16* ST = (u16*)(ws + OFF_ST);
  float run = 0.f;
  float locv[32], decv[32];
#pragma unroll
  for (int c = 0; c < 32; c++) {
    locv[c] = SL[(size_t)(bh * 32 + c) * 16384 + e];
    decv[c] = DC[(bh * 32 + c) * 128 + d];
  }
#pragma unroll
  for (int c = 0; c < 32; c++) {
    ST[(size_t)(bh * 32 + c) * 16384 + e] = f2bf(run);
    run = run * decv[c] + locv[c];
  }
}

__device__ __forceinline__ void hgrn_final(const Params& P, int l, int item, char* smem, size_t ssq_off) {
  gchar* ws = ows(P);
  const int c = item & 31, h = (item >> 5) & 3, b = item >> 7;
  const int t0 = b * 2048 + c * 64;
  const int tid = otid(), lane = tid & 63, wid = tid >> 6, fr = lane & 15, fq = lane >> 4, wr = wid >> 1, wc = wid & 1;
  const u16* QG = (const u16*)(ws + OFF_QG) + (size_t)t0 * 512 + h * 128;
  const u16* ST = (const u16*)(ws + OFF_ST) + (size_t)((b * 4 + h) * 32 + c) * 16384;
  const float* OB = (const float*)(ws + OFF_OBUF) + (size_t)t0 * 512 + h * 128;
  float* tile = (float*)(smem + 27648);
  gemm_tile<64>(QG, 512, ST, 128, 128, smem, NoHook(), [&](f32x4(&acc)[2][4]) {
#pragma unroll
    for (int m = 0; m < 2; m++)
#pragma unroll
      for (int n = 0; n < 4; n++)
#pragma unroll
        for (int j = 0; j < 4; j++) {
          int r = wr * 32 + m * 16 + fq * 4 + j, cc = wc * 64 + n * 16 + fr;
          tile[r * 132 + cc] = acc[m][n][j] + OB[(size_t)r * 512 + cc];
        }
  });
  __syncthreads();
  const float* pb = (const float*)(ws + OFF_PBUF);
  u16* YB = (u16*)(ws + OFF_YBUF);
  float* SS = (float*)(ws + ssq_off);
#pragma unroll 4
  for (int rr = 0; rr < 16; rr++) {
    int r = wid * 16 + rr, t = t0 + r;
    float o0 = tile[r * 132 + lane], o1 = tile[r * 132 + 64 + lane];
    float ss = wave_sum(o0 * o0 + o1 * o1);
    float rstd = rsqrtf(ss * (1.f / 128.f) + EPSF);
    float g0 = pb[(size_t)t * 2816 + 1536 + h * 128 + lane], g1 = pb[(size_t)t * 2816 + 1536 + h * 128 + 64 + lane];
    float y0 = o0 * rstd * siluf_(g0), y1 = o1 * rstd * siluf_(g1);
    YB[(size_t)t * 1024 + h * 128 + lane] = f2bf(y0);
    YB[(size_t)t * 1024 + h * 128 + 64 + lane] = f2bf(y1);
    float s2 = wave_sum(y0 * y0 + y1 * y1);
    if (lane == 0) atomicAdd(&SS[t * 4 + 0], s2);
  }
}

template <bool FINAL>
__device__ __forceinline__ void s5_pass(const Params& P, int l, int item, char* smem) {
  gchar* ws = ows(P);
  const int cq = item & 7, g = (item >> 3) & 15, b = item >> 7;
  const int tid = otid(), lane = tid & 63, w = tid >> 6;
  const int c = cq * 4 + w;
  const int t0 = b * 2048 + c * 64;
  float* Cre = (float*)smem;
  float* Cim = Cre + 1024;
  float* ub = Cim + 1024 + w * 256;
  float2* xs = (float2*)(smem + 8192 + 4096) + w * (16 * 65);
  const float* pb = (const float*)(ws + OFF_PBUF);
  __syncthreads();
  if (FINAL) {
#pragma unroll
    for (int i = 0; i < 4; i++) {
      int idx = tid + i * NTHR, cc = idx >> 6, p = idx & 63;
      Cre[p * 16 + cc] = SMALLP(ws, SM_CRE)[(size_t)(l * 16 + g) * 1024 + idx];
      Cim[p * 16 + cc] = SMALLP(ws, SM_CIM)[(size_t)(l * 16 + g) * 1024 + idx];
    }
  }
  const float* SA = (const float*)(ws + OFF_S5A) + (size_t)((l * 16 + g) * 64 + lane) * 2;
  const float are = SA[0], aim = SA[1];
  float bbr[16], bbi[16];
  {
    const float4* SB = (const float4*)((const float*)(ws + OFF_S5BB) + (size_t)((l * 16 + g) * 64 + lane) * 32);
#pragma unroll
    for (int i = 0; i < 4; i++) {
      float4 v = SB[i];
      bbr[i * 4 + 0] = v.x; bbr[i * 4 + 1] = v.y; bbr[i * 4 + 2] = v.z; bbr[i * 4 + 3] = v.w;
      float4 u = SB[4 + i];
      bbi[i * 4 + 0] = u.x; bbi[i * 4 + 1] = u.y; bbi[i * 4 + 2] = u.z; bbi[i * 4 + 3] = u.w;
    }
  }
  float xr = 0.f, xi = 0.f;
  const size_t sidx = (size_t)((b * 16 + g) * 32 + c) * 64 + lane;
  if (FINAL) {
    float2 x0 = ((const float2*)(ws + OFF_S5XS))[sidx];
    xr = x0.x; xi = x0.y;
  }
  float4 uvn = *(const float4*)(pb + (size_t)(t0 + (lane >> 2)) * 2816 + 2048 + g * 16 + (lane & 3) * 4);
  for (int sub = 0; sub < 4; sub++) {
    __syncthreads();
    *(float4*)(ub + (lane >> 2) * 16 + (lane & 3) * 4) = uvn;
    __syncthreads();
    if (sub < 3)
      uvn = *(const float4*)(pb + (size_t)(t0 + (sub + 1) * 16 + (lane >> 2)) * 2816 + 2048 + g * 16 + (lane & 3) * 4);
#pragma unroll 4
    for (int tt = 0; tt < 16; tt++) {
      float br = 0.f, bi = 0.f;
#pragma unroll
      for (int q = 0; q < 4; q++) {
        float4 uv = *(const float4*)(ub + tt * 16 + q * 4);
        br += uv.x * bbr[q * 4 + 0] + uv.y * bbr[q * 4 + 1] + uv.z * bbr[q * 4 + 2] + uv.w * bbr[q * 4 + 3];
        bi += uv.x * bbi[q * 4 + 0] + uv.y * bbi[q * 4 + 1] + uv.z * bbi[q * 4 + 2] + uv.w * bbi[q * 4 + 3];
      }
      float nxr = are * xr - aim * xi + br;
      float nxi = are * xi + aim * xr + bi;
      xr = nxr; xi = nxi;
      if (FINAL) xs[tt * 65 + lane] = make_float2(xr, xi);
    }
    if (FINAL) {
      __syncthreads();
      int tt = lane >> 2, c4 = (lane & 3) * 4;
      float y0 = 0.f, y1 = 0.f, y2 = 0.f, y3 = 0.f;
#pragma unroll 8
      for (int p = 0; p < 64; p++) {
        float2 x = xs[tt * 65 + p];
        float4 cr = *(const float4*)(Cre + p * 16 + c4);
        float4 ci = *(const float4*)(Cim + p * 16 + c4);
        y0 += x.x * cr.x - x.y * ci.x;
        y1 += x.x * cr.y - x.y * ci.y;
        y2 += x.x * cr.z - x.y * ci.z;
        y3 += x.x * cr.w - x.y * ci.w;
      }
      float4 uv = *(const float4*)(ub + tt * 16 + c4);
      float4 dk = *(const float4*)(SMALLP(ws, SM_S5D) + l * 256 + g * 16 + c4);
      y0 = geluf_(y0 + dk.x * uv.x);
      y1 = geluf_(y1 + dk.y * uv.y);
      y2 = geluf_(y2 + dk.z * uv.z);
      y3 = geluf_(y3 + dk.w * uv.w);
      uint2 o;
      o.x = pack2(y0, y1);
      o.y = pack2(y2, y3);
      *(uint2*)((u16*)(ws + OFF_ZBUF) + (size_t)(t0 + sub * 16 + tt) * 256 + g * 16 + c4) = o;
    }
  }
  if (!FINAL) ((float2*)(ws + OFF_S5E))[sidx] = make_float2(xr, xi);
}

__device__ __forceinline__ void s5_carry(const Params& P, int l, int item) {
  gchar* ws = ows(P);
  const int idx = item * NTHR + otid(), p = idx & 63, g = (idx >> 6) & 15, b = idx >> 10;
  const float* SA = (const float*)(ws + OFF_S5A) + (size_t)((l * 16 + g) * 64 + p) * 2;
  float ar = SA[0], ai = SA[1];
#pragma unroll
  for (int i = 0; i < 6; i++) {
    float nr = ar * ar - ai * ai, ni = 2.f * ar * ai;
    ar = nr; ai = ni;
  }
  float xr = 0.f, xi = 0.f;
  const float2* E = (const float2*)(ws + OFF_S5E);
  float2* XS = (float2*)(ws + OFF_S5XS);
#pragma unroll 16
  for (int c = 0; c < 32; c++) {
    size_t o = (size_t)((b * 16 + g) * 32 + c) * 64 + p;
    XS[o] = make_float2(xr, xi);
    float2 e = E[o];
    float nr = ar * xr - ai * xi + e.x, ni = ar * xi + ai * xr + e.y;
    xr = nr; xi = ni;
  }
}

__device__ __forceinline__ void lru_local(const Params& P, int l, int item, char* smem) {
  gchar* ws = ows(P);
  const int hb = item & 3, c = (item >> 2) & 31, b = item >> 7;
  const int t0 = b * 2048 + c * 64;
  const int tid = otid(), j = tid & 63, tq = tid >> 6, ch = hb * 64 + j;
  float* xcT = (float*)smem;
  float* waL = xcT + 64 * 68;
  float* wxL = waL + 4096;
  float2* comp = (float2*)(wxL + 4096);
  const float* pb = (const float*)(ws + OFF_PBUF);
  __syncthreads();
  float xcv[16];
  {
    const float cw0 = SMALLP(ws, SM_CONVW)[(l * 4 + 0) * 256 + ch], cw1 = SMALLP(ws, SM_CONVW)[(l * 4 + 1) * 256 + ch],
                cw2 = SMALLP(ws, SM_CONVW)[(l * 4 + 2) * 256 + ch], cw3 = SMALLP(ws, SM_CONVW)[(l * 4 + 3) * 256 + ch];
    const float cb = SMALLP(ws, SM_CONVB)[l * 256 + ch];
    const int tl0 = c * 64 + tq * 16;
    const float* xp = pb + (size_t)(t0 + tq * 16) * 2816 + 2304 + ch;
    float xm3 = (tl0 >= 3) ? xp[-3 * 2816] : 0.f;
    float xm2 = (tl0 >= 2) ? xp[-2 * 2816] : 0.f;
    float xm1 = (tl0 >= 1) ? xp[-1 * 2816] : 0.f;
#pragma unroll
    for (int i = 0; i < 16; i++) {
      float xt = xp[(size_t)i * 2816];
      xcv[i] = cw0 * xm3 + cw1 * xm2 + cw2 * xm1 + cw3 * xt + cb;
      xm3 = xm2; xm2 = xm1; xm1 = xt;
    }
#pragma unroll
    for (int q = 0; q < 4; q++)
      *(float4*)(xcT + j * 68 + tq * 16 + q * 4) = make_float4(xcv[q * 4], xcv[q * 4 + 1], xcv[q * 4 + 2], xcv[q * 4 + 3]);
  }
#pragma unroll 4
  for (int i = 0; i < 16; i++) {
    int idx = tid + i * NTHR;
    waL[idx] = SMALLP(ws, SM_WA)[(size_t)(l * 4 + hb) * 4096 + idx];
    wxL[idx] = SMALLP(ws, SM_WX)[(size_t)(l * 4 + hb) * 4096 + idx];
  }
  __syncthreads();
  float accA[16], accX[16];
#pragma unroll
  for (int i = 0; i < 16; i++) { accA[i] = 0.f; accX[i] = 0.f; }
#pragma unroll 2
  for (int i = 0; i < 64; i++) {
    float wa = waL[i * 64 + j], wx = wxL[i * 64 + j];
#pragma unroll
    for (int q = 0; q < 4; q++) {
      float4 xv = *(const float4*)(xcT + i * 68 + tq * 16 + q * 4);
      accA[q * 4 + 0] += xv.x * wa; accA[q * 4 + 1] += xv.y * wa; accA[q * 4 + 2] += xv.z * wa; accA[q * 4 + 3] += xv.w * wa;
      accX[q * 4 + 0] += xv.x * wx; accX[q * 4 + 1] += xv.y * wx; accX[q * 4 + 2] += xv.z * wx; accX[q * 4 + 3] += xv.w * wx;
    }
  }
  const float ba = SMALLP(ws, SM_BA)[l * 256 + ch], bx = SMALLP(ws, SM_BX)[l * 256 + ch];
  const float sp = log1pf(expf(-SMALLP(ws, SM_LAM)[l * 256 + ch]));
  float av[16], bt[16];
  float Pq = 1.f, Hq = 0.f;
#pragma unroll
  for (int i = 0; i < 16; i++) {
    float r = sigmoidf_(accA[i] + ba), ig = sigmoidf_(accX[i] + bx);
    float la = -8.f * r * sp;
    av[i] = expf(la);
    bt[i] = sqrtf(-expm1f(2.f * la)) * (ig * xcv[i]);
    Hq = av[i] * Hq + bt[i];
    Pq *= av[i];
  }
  comp[tq * 64 + j] = make_float2(Pq, Hq);
  __syncthreads();
  float Pin = 1.f, Hin = 0.f;
#pragma unroll
  for (int q = 0; q < 3; q++) {
    if (q < tq) {
      float2 cq2 = comp[q * 64 + j];
      Hin = cq2.x * Hin + cq2.y;
      Pin *= cq2.x;
    }
  }
  float* HL = (float*)(ws + OFF_HLOC);
  float* PC = (float*)(ws + OFF_PCUM);
#pragma unroll
  for (int i = 0; i < 16; i++) {
    Hin = av[i] * Hin + bt[i];
    Pin *= av[i];
    size_t o = (size_t)(t0 + tq * 16 + i) * 256 + ch;
    HL[o] = Hin;
    PC[o] = Pin;
  }
}

__device__ __forceinline__ void lru_carry(const Params& P, int item) {
  gchar* ws = ows(P);
  const int idx = item * NTHR + otid(), ch = idx & 255, b = idx >> 8;
  const float* HL = (const float*)(ws + OFF_HLOC);
  const float* PC = (const float*)(ws + OFF_PCUM);
  float* HS = (float*)(ws + OFF_HST);
  float H = 0.f;
#pragma unroll 16
  for (int c = 0; c < 32; c++) {
    HS[(b * 32 + c) * 256 + ch] = H;
    size_t o = (size_t)(b * 2048 + c * 64 + 63) * 256 + ch;
    H = PC[o] * H + HL[o];
  }
}

__device__ __forceinline__ void lru_final(const Params& P, int l, int item, size_t ssq_off) {
  gchar* ws = ows(P);
  const int lane = otid() & 63, w = otid() >> 6;
  const float* HL = (const float*)(ws + OFF_HLOC);
  const float* PC = (const float*)(ws + OFF_PCUM);
  const float* HS = (const float*)(ws + OFF_HST);
  const float* pb = (const float*)(ws + OFF_PBUF);
  u16* YB = (u16*)(ws + OFF_YBUF);
  float* SS = (float*)(ws + ssq_off);
  for (int i = 0; i < 16; i++) {
    int t = item * 64 + w * 16 + i;
    int b = t >> 11, c = (t & 2047) >> 6;
    float4 hl = *(const float4*)(HL + (size_t)t * 256 + lane * 4);
    float4 pc = *(const float4*)(PC + (size_t)t * 256 + lane * 4);
    float4 hs = *(const float4*)(HS + (b * 32 + c) * 256 + lane * 4);
    float4 z = *(const float4*)(pb + (size_t)t * 2816 + 2560 + lane * 4);
    float y0 = (hl.x + pc.x * hs.x) * geluf_(z.x);
    float y1 = (hl.y + pc.y * hs.y) * geluf_(z.y);
    float y2 = (hl.z + pc.z * hs.z) * geluf_(z.z);
    float y3 = (hl.w + pc.w * hs.w) * geluf_(z.w);
    uint2 o;
    o.x = pack2(y0, y1);
    o.y = pack2(y2, y3);
    *(uint2*)(YB + (size_t)t * 1024 + 768 + lane * 4) = o;
    float s = wave_sum(y0 * y0 + y1 * y1 + y2 * y2 + y3 * y3);
    if (lane == 0) SS[t * 4 + 2] = s;
  }
}

__device__ __forceinline__ void phase_glu(const Params& P, int l, char* smem) {
  gchar* ws = ows(P);
  const u16* ZB = (const u16*)(ws + OFF_ZBUF);
  const u16* W = (const u16*)(ws + OFF_WGT) + (size_t)l * 65536;
  u16* YB = (u16*)(ws + OFF_YBUF);
  float* SS = (float*)(ws + OFF_SSQ) + (size_t)l * NTOK * 4;
  const float* bg = SMALLP(ws, SM_BGLU) + l * 256;
  const int lane = otid() & 63, wid = otid() >> 6, fr = lane & 15, fq = lane >> 4, wr = wid >> 1, wc = wid & 1;
  for (int tile = blockIdx.x; tile < 256; tile += gridDim.x) {
    int mt = tile >> 1, nt = tile & 1;
    gemm_tile<128>(ZB + (size_t)mt * 128 * 256, 256, W + (size_t)nt * 128 * 256, 256, 256, smem, NoHook(),
                   [&](f32x4(&acc)[4][4]) {
#pragma unroll
                     for (int m = 0; m < 4; m++)
#pragma unroll
                       for (int j = 0; j < 4; j++) {
                         int t = mt * 128 + wr * 64 + m * 16 + fq * 4 + j;
                         float s = 0.f;
#pragma unroll
                         for (int n = 0; n < 4; n++) {
                           int col = nt * 128 + wc * 64 + n * 16 + fr;
                           float z = bf2f(ZB[(size_t)t * 256 + col]);
                           float y = z * sigmoidf_(acc[m][n][j] + bg[col]);
                           YB[(size_t)t * 1024 + 512 + col] = f2bf(y);
                           s += y * y;
                         }
                         s = row_sum16(s);
                         if (fr == 0) atomicAdd(&SS[t * 4 + 1], s);
                       }
                   });
  }
}

__device__ __forceinline__ void phase_gemm_out(const Params& P, int l, char* smem) {
  gchar* ws = ows(P);
  const u16* YB = (const u16*)(ws + OFF_YBUF);
  const u16* W = (const u16*)(ws + OFF_WOUTT) + (size_t)l * 1048576;
  const float* SS = (const float*)(ws + OFF_SSQ) + (size_t)l * NTOK * 4;
  const float* xin = (l == 0) ? P.in[I_X] : (const float*)(ws + OFF_XRES);
  float* XR = (float*)(ws + OFF_XRES);
  const float* modl = (const float*)(ws + OFF_MOD) + (size_t)l * 8 * 6144;
  const int lane = otid() & 63, wid = otid() >> 6, fr = lane & 15, fq = lane >> 4, wr = wid >> 1, wc = wid & 1;
  XCD_TILE_LOOP(8, 512) {
    int mt, nt;
    if (!xcd_tile(i_, 8, 512, smem, mt, nt, more_)) continue;
    float* rsc = (float*)(smem + 55296);
    __syncthreads();
    {
      const int r_ = otid();
      const float* sq = SS + (size_t)(mt * 256 + r_) * 4;
      float ra = rsqrtf(sq[0] * (1.f / 512.f) + EPSF);
      float rb = rsqrtf(sq[1] * (1.f / 256.f) + EPSF);
      float rc = rsqrtf(sq[2] * (1.f / 256.f) + EPSF);
      rsc[r_ * 4 + 0] = ra / rb;
      rsc[r_ * 4 + 1] = rb / rc;
      rsc[r_ * 4 + 2] = rc;
    }
    gemm_tile256(
        YB + (size_t)mt * 256 * 1024, 1024, W + (size_t)nt * 128 * 1024, 1024, 1024, smem,
        [&](int kt, f32x4(&acc)[8][4]) {
          if (kt == 7 || kt == 11 || kt == 15) {
            const int t_ = otid(), l_ = t_ & 63, w_ = t_ >> 6, fq = l_ >> 4, wr = w_ >> 1;
#pragma unroll
            for (int m = 0; m < 8; m++)
#pragma unroll
              for (int j = 0; j < 4; j++) {
                float f = rsc[(wr * 128 + fq * 4 + m * 16 + j) * 4 + ((kt == 7) ? 0 : ((kt == 11) ? 1 : 2))];
#pragma unroll
                for (int n = 0; n < 4; n++) acc[m][n][j] *= f;
              }
          }
        },
        [&](f32x4(&acc)[8][4]) {
          const int t_ = otid(), l_ = t_ & 63, w_ = t_ >> 6, fr = l_ & 15, fq = l_ >> 4, wr = w_ >> 1, wc = w_ & 1;
          const float* gt = modl + (size_t)(mt >> 3) * 6144 + 2048 + nt * 128 + wc * 64;
#pragma unroll
          for (int m = 0; m < 8; m++)
#pragma unroll
            for (int j = 0; j < 4; j++) {
              const size_t o = (size_t)(mt * 256 + wr * 128 + fq * 4 + m * 16 + j) * 1024 + nt * 128 + wc * 64 + fr;
#pragma unroll
              for (int n = 0; n < 4; n++) XR[o + n * 16] = xin[o + n * 16] + gt[n * 16 + fr] * acc[m][n][j];
            }
        });
  }
}

__device__ __forceinline__ void phase_gemm_q(const Params& P, int l, char* smem) {
  gchar* ws = ows(P);
  const u16* HB = (const u16*)(ws + OFF_HBUF);
  const u16* W = (const u16*)(ws + OFF_WQT) + (size_t)l * 2048 * 1024;
  u16* QB = (u16*)(ws + OFF_QBUF);
  const int lane = otid() & 63, wid = otid() >> 6, fr = lane & 15, fq = lane >> 4, wr = wid >> 1, wc = wid & 1;
  XCD_TILE_LOOP(16, 1024) {
    int mt, nt;
    if (!xcd_tile(i_, 16, 1024, smem, mt, nt, more_)) continue;
    gemm_tile256(HB + (size_t)mt * 256 * 1024, 1024, W + (size_t)nt * 128 * 1024, 1024, 1024, smem, NoHook(),
                 [&](f32x4(&acc)[8][4]) {
                   const int t_ = otid(), l_ = t_ & 63, w_ = t_ >> 6, fr = l_ & 15, fq = l_ >> 4, wr = w_ >> 1, wc = w_ & 1;
#pragma unroll
                   for (int m = 0; m < 8; m++)
#pragma unroll
                     for (int j = 0; j < 4; j++) {
                       u16* rp = QB + (size_t)(mt * 256 + wr * 128 + m * 16 + fq * 4 + j) * 2048 + nt * 128 + wc * 64 + fr;
#pragma unroll
                       for (int n = 0; n < 4; n++) rp[n * 16] = f2bf(acc[m][n][j]);
                     }
                 });
  }
}

template <int CTRL>
__device__ __forceinline__ void topk_merge(float (&top)[16]) {
  float c[16];
#pragma unroll
  for (int i = 0; i < 16; i++) c[i] = fmaxf(top[i], dpp_mov<CTRL>(top[15 - i]));
#pragma unroll
  for (int dd = 8; dd >= 1; dd >>= 1)
#pragma unroll
    for (int i = 0; i < 16; i++)
      if ((i & dd) == 0) {
        float hi = fmaxf(c[i], c[i + dd]), lo = fminf(c[i], c[i + dd]);
        c[i] = hi;
        c[i + dd] = lo;
      }
#pragma unroll
  for (int i = 0; i < 16; i++) top[i] = c[i];
}

__device__ __forceinline__ void phase_scores(const Params& P, int l, char* smem) {
  gchar* ws = ows(P);
  const u16* QB = (const u16*)(ws + OFF_QBUF);
  const u16* KB = (const u16*)(ws + OFF_KEYS) + (size_t)l * 2 * 16384;
  float* STP = (float*)(ws + OFF_STOP);
  const int tid = otid(), lane = tid & 63, wid = tid >> 6, fr = lane & 15, fq = lane >> 4, wr = wid >> 1, wc = wid & 1;
  float* tile = (float*)(smem + 27648);
  for (int it = blockIdx.x; it < 4096; it += gridDim.x) {
    int p = it & 1, R0 = (it >> 1) * 64;
    gemm_tile<64>(QB + (size_t)R0 * 256 + p * 128, 256, KB + (size_t)p * 16384, 128, 128, smem, NoHook(),
                  [&](f32x4(&acc)[2][4]) {
#pragma unroll
                    for (int m = 0; m < 2; m++)
#pragma unroll
                      for (int n = 0; n < 4; n++)
#pragma unroll
                        for (int j = 0; j < 4; j++)
                          tile[(wr * 32 + m * 16 + fq * 4 + j) * 132 + wc * 64 + n * 16 + fr] = acc[m][n][j];
                  });
    __syncthreads();
    {
      const int r = tid >> 2, part = tid & 3;
      float top[16];
#pragma unroll
      for (int i = 0; i < 16; i++) top[i] = -3.0e38f;
#pragma unroll 2
      for (int i = 0; i < 32; i++) {
        const int k = i * 4 + part;
        float v = __uint_as_float((__float_as_uint(tile[r * 132 + k]) & ~0x7Fu) | (unsigned)k);
#pragma unroll
        for (int q = 0; q < 16; q++) {
          float hi = fmaxf(top[q], v);
          v = fminf(top[q], v);
          top[q] = hi;
        }
      }
      topk_merge<0xB1>(top);
      topk_merge<0x4E>(top);
      if (part == 0) {
        float4* o = (float4*)(STP + ((size_t)(R0 + r) * 2 + p) * 16);
        o[0] = make_float4(top[0], top[1], top[2], top[3]);
        o[1] = make_float4(top[4], top[5], top[6], top[7]);
        o[2] = make_float4(top[8], top[9], top[10], top[11]);
        o[3] = make_float4(top[12], top[13], top[14], top[15]);
      }
    }
  }
}

typedef __attribute__((ext_vector_type(2))) __bf16 bf2_t;
__device__ __forceinline__ float dot2bf(unsigned a, unsigned b, float c) {
  return __builtin_amdgcn_fdot2_f32_bf16(__builtin_bit_cast(bf2_t, a), __builtin_bit_cast(bf2_t, b), c, false);
}
template <bool DRY>
__device__ __forceinline__ void phase_peer(const Params& P, int l, char* smem) {
  gchar* ws = ows(P);
  const int tid = otid(), lane = tid & 63, w = tid >> 6;
  int2* SP = (int2*)smem;
  int* START = (int*)(smem + 32768);
  int* CNT = (int*)(smem + 32768 + 2176);
  const float* STP = (const float*)(ws + OFF_STOP);
  u16* HB = (u16*)(ws + OFF_HBUF);
  float* XR = (float*)(ws + OFF_XRES);
  const u16* UB = (const u16*)(ws + OFF_UB) + (size_t)l * 16384 * 1024;
  const u16* VB = (const u16*)(ws + OFF_VB) + (size_t)l * 16384 * 1024;
  const float* modl = (const float*)(ws + OFF_MOD) + (size_t)l * 8 * 6144;
  const float* modn = (const float*)(ws + OFF_MOD) + (size_t)(l + 1) * 8 * 6144;
  for (int item = blockIdx.x; item < 512; item += gridDim.x) {
    const int tok0 = item * 32;
    __syncthreads();
    for (int i = tid; i < 512; i += NTHR) CNT[i] = 0;
    __syncthreads();
    {
      const int tt = tid >> 3, h = tid & 7, t = tok0 + tt;
      const float* s1p = STP + ((size_t)(t * 8 + h) * 2 + 0) * 16;
      const float* s2p = s1p + 16;
      float s1[16], s2[16];
#pragma unroll
      for (int i = 0; i < 4; i++) {
        float4 a4 = ((const float4*)s1p)[i], bq = ((const float4*)s2p)[i];
        s1[i * 4] = a4.x; s1[i * 4 + 1] = a4.y; s1[i * 4 + 2] = a4.z; s1[i * 4 + 3] = a4.w;
        s2[i * 4] = bq.x; s2[i * 4 + 1] = bq.y; s2[i * 4 + 2] = bq.z; s2[i * 4 + 3] = bq.w;
      }
#pragma unroll
      for (int i = 0; i < 16; i++) {
        s1[i] = __uint_as_float(__float_as_uint(s1[i]) & ~0x7Fu);
        s2[i] = __uint_as_float(__float_as_uint(s2[i]) & ~0x7Fu);
      }
      float top[16];
#pragma unroll
      for (int i = 0; i < 16; i++) top[i] = -3.0e38f;
#pragma unroll
      for (int i = 0; i < 16; i++)
#pragma unroll
        for (int j = 0; j < 16; j++)
          if ((i + 1) * (j + 1) <= 16) {
            float v = __uint_as_float((__float_as_uint(s1[i] + s2[j]) & ~0xFFu) | (unsigned)(i * 16 + j));
#pragma unroll
            for (int q = 0; q < 16; q++) {
              float hi = fmaxf(top[q], v);
              v = fminf(top[q], v);
              top[q] = hi;
            }
          }
      const float mx = __uint_as_float(__float_as_uint(top[0]) & ~0xFFu);
      float ev[16], sum = 0.f;
      int exv[16], pos[16];
#pragma unroll
      for (int k = 0; k < 16; k++) {
        unsigned bits = __float_as_uint(top[k]);
        int code = bits & 0xFF;
        int i1 = __float_as_uint(s1p[code >> 4]) & 0x7F;
        int i2 = __float_as_uint(s2p[code & 15]) & 0x7F;
        exv[k] = i1 * 128 + i2;
        ev[k] = __expf(__uint_as_float(bits & ~0xFFu) - mx);
        sum += ev[k];
        pos[k] = atomicAdd(&CNT[tt * 16 + (exv[k] >> 10)], 1);
      }
      const float inv = 1.f / sum;
      __syncthreads();
      if (tid < 32) {
        int run = 0;
        for (int sl = 0; sl < 16; sl++) {
          START[tid * 17 + sl] = run;
          run += CNT[tid * 16 + sl];
        }
        START[tid * 17 + 16] = run;
      }
      __syncthreads();
#pragma unroll
      for (int k = 0; k < 16; k++)
        SP[tt * 128 + START[tt * 17 + (exv[k] >> 10)] + pos[k]] = make_int2(exv[k], __float_as_int(ev[k] * inv));
    }
    __syncthreads();
#define PEER_RFL(x) __builtin_amdgcn_readfirstlane(x)
#define PEER_ISSUE(R, TAB, TT, PB, N, BB)                                                    \
  {                                                                                          \
    _Pragma("unroll") for (int k_ = 0; k_ < (BB); k_++) {                                       \
      const bool valid_ = k_ < (N);                                                          \
      const int e_ = valid_ ? PEER_RFL(SP[(TT) * 128 + (PB) + k_].x) : 0;                    \
      const u32x4* p_ = (const u32x4*)((TAB) + (size_t)e_ * 1024);                           \
      R[k_][0] = p_[valid_ ? lane : 0];                                                      \
      R[k_][1] = p_[valid_ ? lane + 64 : 0];                                                 \
    }                                                                                        \
  }
#define PEER_TRED(D0, D1, D2, D3, E)                                                         \
  {                                                                                          \
    float a0_ = hi5 ? D1 : D0, b0_ = hi5 ? D0 : D1;                                          \
    a0_ += __int_as_float(__builtin_amdgcn_ds_bpermute((lane ^ 32) << 2, __float_as_int(b0_)));                                                              \
    float a1_ = hi5 ? D3 : D2, b1_ = hi5 ? D2 : D3;                                          \
    a1_ += __int_as_float(__builtin_amdgcn_ds_bpermute((lane ^ 32) << 2, __float_as_int(b1_)));                                                              \
    float e_ = hi4 ? a1_ : a0_, f_ = hi4 ? a0_ : a1_;                                        \
    e_ += __int_as_float(__builtin_amdgcn_ds_bpermute((lane ^ 16) << 2, __float_as_int(f_)));                                                                \
    E = row_sum16(e_);                                                                       \
  }
#ifdef PEER_ALIGN
    { XcdBarrier xb_; xb_.bar = (unsigned*)(ows(P) + OFF_BAR); xb_.x = xb_xcc_id(); xb_.st = (volatile LAS unsigned*)(smem + 65520); xcd_barrier_exec(xb_); }
#endif
    const bool hi5 = (lane & 32) != 0, hi4 = (lane & 16) != 0;
    const int rowi = lane >> 4;
    const int slot_of_row = ((rowi & 1) << 1) | (rowi >> 1);
    {
      constexpr int BU = 4;
      const int ttu = w * 8;
      {
        unsigned hp[8][8];
#pragma unroll
        for (int j = 0; j < 8; j++) {
          const int t = tok0 + ttu + j;
          const u32x4* hptr = (const u32x4*)(HB + (size_t)t * 1024);
          u32x4 hA = hptr[lane], hB2 = hptr[64 + lane];
          hp[j][0] = hA.x; hp[j][1] = hA.y; hp[j][2] = hA.z; hp[j][3] = hA.w;
          hp[j][4] = hB2.x; hp[j][5] = hB2.y; hp[j][6] = hB2.z; hp[j][7] = hB2.w;
        }
        u32x4 cur[BU][2], nxt[BU][2];
        {
          const int p0f = PEER_RFL(START[ttu * 17]), p1f = PEER_RFL(START[ttu * 17 + 1]);
          const int nf = min(BU, p1f - p0f);
          PEER_ISSUE(cur, UB, ttu, p0f, nf, BU)
        }
        for (int sl = 0; sl < 16; sl++) {
#pragma unroll
          for (int j = 0; j < 8; j++) {
            const int tt = ttu + j;
            const int p0 = PEER_RFL(START[tt * 17 + sl]), p1 = PEER_RFL(START[tt * 17 + sl + 1]);
            const int ttn = (j < 7) ? tt + 1 : ttu;
            const int sln = (j < 7) ? sl : sl + 1;
            int np0 = 0, np1 = 0;
            if (sln < 16) {
              np0 = PEER_RFL(START[ttn * 17 + sln]);
              np1 = PEER_RFL(START[ttn * 17 + sln + 1]);
            }
            int pb = p0;
            do {
              const int n = min(BU, p1 - pb);
              int nt, npb, nn;
              if (pb + BU < p1) { nt = tt; npb = pb + BU; nn = min(BU, p1 - npb); }
              else { nt = ttn; npb = np0; nn = min(BU, np1 - np0); }
              PEER_ISSUE(nxt, UB, nt, npb, nn, BU)
              float d[8];
#pragma unroll
              for (int k = 0; k < 8; k++) d[k] = 0.f;
#pragma unroll
              for (int k = 0; k < BU; k++) {
                float d_ = 0.f;
                d_ = dot2bf(cur[k][0].x, hp[j][0], d_); d_ = dot2bf(cur[k][0].y, hp[j][1], d_);
                d_ = dot2bf(cur[k][0].z, hp[j][2], d_); d_ = dot2bf(cur[k][0].w, hp[j][3], d_);
                d_ = dot2bf(cur[k][1].x, hp[j][4], d_); d_ = dot2bf(cur[k][1].y, hp[j][5], d_);
                d_ = dot2bf(cur[k][1].z, hp[j][6], d_); d_ = dot2bf(cur[k][1].w, hp[j][7], d_);
                d[k] = d_;
              }
              float e0, e1;
              PEER_TRED(d[0], d[1], d[2], d[3], e0)
              PEER_TRED(d[4], d[5], d[6], d[7], e1)
              {
                const bool va = slot_of_row < n, vb = slot_of_row + 4 < n;
                const int ia = tt * 128 + pb + slot_of_row;
                const float ga = __int_as_float(SP[va ? ia : tt * 128].y);
                const float gb = __int_as_float(SP[vb ? ia + 4 : tt * 128].y);
                const float wa = ga * geluf_(e0), wb = gb * geluf_(e1);
                if ((lane & 15) == 0) {
                  if (va) SP[ia].y = __float_as_int(wa);
                  if (vb) SP[ia + 4].y = __float_as_int(wb);
                }
              }
#pragma unroll
              for (int k = 0; k < BU; k++) { cur[k][0] = nxt[k][0]; cur[k][1] = nxt[k][1]; }
              pb += BU;
            } while (pb < p1);
          }
        }
      }
    }
    for (int r = 0; r < 2; r++) {
      const int ttb = w * 8 + r * 4;
#ifdef PEER_ALIGN
      { XcdBarrier xb_; xb_.bar = (unsigned*)(ows(P) + OFF_BAR); xb_.x = xb_xcc_id(); xb_.st = (volatile LAS unsigned*)(smem + 65520); xcd_barrier_exec(xb_); }
#endif
      float out[4][16];
#pragma unroll
      for (int j = 0; j < 4; j++)
#pragma unroll
        for (int i = 0; i < 16; i++) out[j][i] = 0.f;
      {
        constexpr int BV = 6;
        u32x4 cur[BV][2], nxt[BV][2];
        {
          const int sl0 = r ? 15 : 0;
          const int p0f = PEER_RFL(START[ttb * 17 + sl0]), p1f = PEER_RFL(START[ttb * 17 + sl0 + 1]);
          const int nf = min(BV, p1f - p0f);
          PEER_ISSUE(cur, VB, ttb, p0f, nf, BV)
        }
        for (int sl = 0; sl < 16; sl++) {
#pragma unroll
          for (int j = 0; j < 4; j++) {
            const int tt = ttb + j;
            const int sle = r ? 15 - sl : sl;
            const int p0 = PEER_RFL(START[tt * 17 + sle]), p1 = PEER_RFL(START[tt * 17 + sle + 1]);
            const int ttn = (j < 3) ? tt + 1 : ttb;
            const int sln = (j < 3) ? sl : sl + 1;
            int np0 = 0, np1 = 0;
            if (sln < 16) {
              const int slne = r ? 15 - sln : sln;
              np0 = PEER_RFL(START[ttn * 17 + slne]);
              np1 = PEER_RFL(START[ttn * 17 + slne + 1]);
            }
            int pb = p0;
            do {
              const int n = min(BV, p1 - pb);
              int nt, npb, nn;
              if (pb + BV < p1) { nt = tt; npb = pb + BV; nn = min(BV, p1 - npb); }
              else { nt = ttn; npb = np0; nn = min(BV, np1 - np0); }
              PEER_ISSUE(nxt, VB, nt, npb, nn, BV)
#pragma unroll
              for (int k = 0; k < BV; k++) {
                const float wv = (k < n) ? __int_as_float(PEER_RFL(SP[tt * 128 + pb + k].y)) : 0.f;
                const unsigned wlo = (unsigned)f2bf(wv), whi = wlo << 16;
                out[j][0] = dot2bf(cur[k][0].x, wlo, out[j][0]); out[j][1] = dot2bf(cur[k][0].x, whi, out[j][1]);
                out[j][2] = dot2bf(cur[k][0].y, wlo, out[j][2]); out[j][3] = dot2bf(cur[k][0].y, whi, out[j][3]);
                out[j][4] = dot2bf(cur[k][0].z, wlo, out[j][4]); out[j][5] = dot2bf(cur[k][0].z, whi, out[j][5]);
                out[j][6] = dot2bf(cur[k][0].w, wlo, out[j][6]); out[j][7] = dot2bf(cur[k][0].w, whi, out[j][7]);
                out[j][8] = dot2bf(cur[k][1].x, wlo, out[j][8]); out[j][9] = dot2bf(cur[k][1].x, whi, out[j][9]);
                out[j][10] = dot2bf(cur[k][1].y, wlo, out[j][10]); out[j][11] = dot2bf(cur[k][1].y, whi, out[j][11]);
                out[j][12] = dot2bf(cur[k][1].z, wlo, out[j][12]); out[j][13] = dot2bf(cur[k][1].z, whi, out[j][13]);
                out[j][14] = dot2bf(cur[k][1].w, wlo, out[j][14]); out[j][15] = dot2bf(cur[k][1].w, whi, out[j][15]);
              }
#pragma unroll
              for (int k = 0; k < BV; k++) { cur[k][0] = nxt[k][0]; cur[k][1] = nxt[k][1]; }
              pb += BV;
            } while (pb < p1);
          }
        }
      }
#pragma unroll
      for (int j = 0; j < 4; j++) {
        const int t = tok0 + w * 8 + r * 4 + j;
        const int b = t >> 11;
        float xn[16];
        float ss = 0.f;
#pragma unroll
        for (int hf2 = 0; hf2 < 2; hf2++) {
          const int col = hf2 * 512 + lane * 8;
          float4 x0 = *(const float4*)(XR + (size_t)t * 1024 + col), x1 = *(const float4*)(XR + (size_t)t * 1024 + col + 4);
          float4 g0 = *(const float4*)(modl + (size_t)b * 6144 + 5120 + col), g1 = *(const float4*)(modl + (size_t)b * 6144 + 5120 + col + 4);
          float* o = &out[j][hf2 * 8];
          float* x = xn + hf2 * 8;
          x[0] = x0.x + g0.x * o[0]; x[1] = x0.y + g0.y * o[1]; x[2] = x0.z + g0.z * o[2]; x[3] = x0.w + g0.w * o[3];
          x[4] = x1.x + g1.x * o[4]; x[5] = x1.y + g1.y * o[5]; x[6] = x1.z + g1.z * o[6]; x[7] = x1.w + g1.w * o[7];
#pragma unroll
          for (int i = 0; i < 8; i++) ss += x[i] * x[i];
        }
        ss = wave_sum(ss);
        const float rstd = rsqrtf(ss * (1.f / 1024.f) + EPSF);
        if (DRY) {
          if (rstd == 123.456f) P.out[lane] = rstd;
        } else if (l < 3) {
#pragma unroll
          for (int hf2 = 0; hf2 < 2; hf2++) {
            const int col = hf2 * 512 + lane * 8;
            float* x = xn + hf2 * 8;
            *(float4*)(XR + (size_t)t * 1024 + col) = make_float4(x[0], x[1], x[2], x[3]);
            *(float4*)(XR + (size_t)t * 1024 + col + 4) = make_float4(x[4], x[5], x[6], x[7]);
            const float* gm = SMALLP(ws, SM_GMIX) + (l + 1) * 1024 + col;
            const float* sc = modn + (size_t)b * 6144 + 1024 + col;
            const float* sh = modn + (size_t)b * 6144 + col;
            float hv[8];
#pragma unroll
            for (int i = 0; i < 8; i++) hv[i] = x[i] * rstd * gm[i] * (1.f + sc[i]) + sh[i];
            uint4 o;
            o.x = pack2(hv[0], hv[1]); o.y = pack2(hv[2], hv[3]); o.z = pack2(hv[4], hv[5]); o.w = pack2(hv[6], hv[7]);
            *(uint4*)(HB + (size_t)t * 1024 + col) = o;
          }
        } else {
#pragma unroll
          for (int hf2 = 0; hf2 < 2; hf2++) {
            const int col = hf2 * 512 + lane * 8;
            float* x = xn + hf2 * 8;
            const float* gf = SMALLP(ws, SM_GFINAL) + col;
            *(float4*)(P.out + (size_t)t * 1024 + col) = make_float4(x[0] * rstd * gf[0], x[1] * rstd * gf[1], x[2] * rstd * gf[2], x[3] * rstd * gf[3]);
            *(float4*)(P.out + (size_t)t * 1024 + col + 4) = make_float4(x[4] * rstd * gf[4], x[5] * rstd * gf[5], x[6] * rstd * gf[6], x[7] * rstd * gf[7]);
          }
        }
      }
    }
  }
}

#ifndef MLM
#define MLM 7
#endif
__device__ __forceinline__ void phase_mix_local(const Params& P, int l, char* smem) {
  for (int item = blockIdx.x; item < 3072; item += gridDim.x) {
    if (item < 1024) { if (MLM & 1) hgrn_local(P, l, item, smem); }
    else if (item < 2048) { if (MLM & 2) s5_pass<false>(P, l, item - 1024, smem); }
    else { if (MLM & 4) lru_local(P, l, item - 2048, smem); }
  }
}
__device__ __forceinline__ void phase_mix_carry(const Params& P, int l) {
  for (int item = blockIdx.x; item < 2048 + 32 + 8; item += gridDim.x) {
    if (item < 2048) hgrn_carry(P, item);
    else if (item < 2080) s5_carry(P, l, item - 2048);
    else lru_carry(P, item - 2080);
  }
}
template <bool DRY>
__device__ __forceinline__ void phase_mix_final(const Params& P, int l, char* smem) {
  const size_t ssq_off = DRY ? OFF_STOP : (OFF_SSQ + (size_t)l * NTOK * 4 * sizeof(float));
  for (int item = blockIdx.x; item < 1024 + 1024 + 256; item += gridDim.x) {
    if (item < 1024) hgrn_final(P, l, item, smem, ssq_off);
    else if (item < 2048) s5_pass<true>(P, l, item - 1024, smem);
    else lru_final(P, l, item - 2048, ssq_off);
  }
}

#ifndef PHM
#define PHM 0xFFFF
#endif
#define PHON(k) ((PHM >> (k)) & 1)
#ifdef TIMEPROBE
#define TP(var) { long long now_ = wall_clock64(); var += (double)(now_ - tlast); tlast = now_; }
#else
#define TP(var)
#endif
__global__ void __launch_bounds__(NTHR, 2) mega_kernel(Params P) {
  __shared__ __attribute__((aligned(16))) char smem[65536];
  cg::grid_group grid = cg::this_grid();
  gchar* ws = ows(P);
  if (ws == nullptr) grid.sync();
  volatile LAS unsigned* xb_st = (volatile LAS unsigned*)(smem + 65520);
  if (threadIdx.x == 0) { xb_st[0] = 0u; xb_st[1] = 0u; }
  __syncthreads();
  (void)xcd_barrier_post((unsigned*)(ws + OFF_BAR), xb_st);
  if (threadIdx.x == 0) {
    const unsigned xcc_ = xb_xcc_id();
    xb_st[3] = xcc_;
    xb_st[2] = xb_add((unsigned*)(ws + OFF_BAR) + XB_RANK(xcc_), 1u);
  }
  __syncthreads();
#define GSYNC() { XcdBarrier xb_; xb_.bar = (unsigned*)(ows(P) + OFF_BAR); xb_.x = xb_xcc_id(); xb_.st = (volatile LAS unsigned*)(smem + 65520); xcd_barrier(xb_); }
#ifdef TIMEPROBE
  double t_prep = 0, t_norm = 0, t_gin = 0, t_ml = 0, t_mc = 0, t_mf = 0, t_glu = 0, t_gout = 0, t_gq = 0, t_sc = 0, t_peer = 0;
  long long tlast = wall_clock64();
#endif
  if (PHON(0)) phase_prep(P, smem);
  GSYNC();
  if (threadIdx.x == 0) {
    bool ok_ = gridDim.x == 512u;
    unsigned* bar_ = (unsigned*)(ws + OFF_BAR);
    for (unsigned j = 0; j < 16; ++j) {
      const unsigned c_ = xb_ld(&bar_[XB_XCNT(j)]);
      ok_ = ok_ && (c_ == ((j < 8u) ? 64u : 0u));
    }
    if (!ok_) xb_st[2] = 0xFFFFFFFFu;
  }
  __syncthreads();
  TP(t_prep)
  phase_norm(P.in[I_X], SMALLP(ws, SM_GMIX), (const float*)(ws + OFF_MOD), 0, 1024, (u16*)(ws + OFF_HBUF));
  GSYNC();
  TP(t_norm)
  for (int l = 0; l < 4; l++) {
#ifdef DUP_GEMM
    phase_gemm_in(P, l, smem);
    GSYNC();
#endif
    if (PHON(1)) phase_gemm_in(P, l, smem);
    GSYNC();
#ifdef DUP_SYNC
    for (int z = 0; z < 10; z++) GSYNC();
#endif
    TP(t_gin)
#ifdef DUP_MIX
    phase_mix_local(P, l, smem);
    GSYNC();
#endif
    if (PHON(2)) phase_mix_local(P, l, smem);
    GSYNC();
    TP(t_ml)
#ifdef DUP_MIX
    phase_mix_carry(P, l);
    GSYNC();
#endif
    if (PHON(3)) phase_mix_carry(P, l);
    GSYNC();
    TP(t_mc)
#ifdef DUP_MF
    phase_mix_final<true>(P, l, smem);
    GSYNC();
#endif
    if (PHON(4)) phase_mix_final<false>(P, l, smem);
    GSYNC();
    TP(t_mf)
    if (PHON(5)) phase_glu(P, l, smem);
    GSYNC();
    TP(t_glu)
    if (PHON(6)) phase_gemm_out(P, l, smem);
    GSYNC();
    TP(t_gout)
    phase_norm((const float*)(ws + OFF_XRES), SMALLP(ws, SM_GFFN) + l * 1024, (const float*)(ws + OFF_MOD) + (size_t)l * 8 * 6144,
               3072, 4096, (u16*)(ws + OFF_HBUF));
    GSYNC();
    TP(t_norm)
#ifdef DUP_GEMM
    phase_gemm_q(P, l, smem);
    GSYNC();
#endif
    if (PHON(7)) phase_gemm_q(P, l, smem);
    GSYNC();
    TP(t_gq)
#ifdef DUP_SC
    phase_scores(P, l, smem);
    GSYNC();
#endif
    if (PHON(8)) phase_scores(P, l, smem);
    GSYNC();
    TP(t_sc)
#ifdef DUP_PEER
    phase_peer<true>(P, l, smem);
    GSYNC();
#endif
    if (PHON(9)) phase_peer<false>(P, l, smem);
    GSYNC();
    TP(t_peer)
  }
#ifdef TIMEPROBE
  if (blockIdx.x == 0) {
    float* sh = (float*)smem;
    __syncthreads();
    if (threadIdx.x == 0) {
      double total = t_prep + t_norm + t_gin + t_ml + t_mc + t_mf + t_glu + t_gout + t_gq + t_sc + t_peer;
      double pa, pb, pc, pd;
#if TIMEPROBE == 1
      pa = t_peer; pb = t_gin + t_gout + t_gq; pc = t_ml + t_mc + t_mf + t_glu; pd = t_sc;
#elif TIMEPROBE == 2
      pa = t_ml; pb = t_mf; pc = t_gin; pd = t_prep;
#else
      pa = t_gq; pb = t_gout; pc = t_norm + t_mc + t_glu; pd = t_mc;
#endif
      int m1 = (int)(100.0 * pa / total + 0.5); m1 = m1 < 10 ? 10 : (m1 > 99 ? 99 : m1);
      int e1 = (int)(100.0 * pb / total / 4.0 + 0.5); e1 = e1 > 25 ? 25 : e1;
      int m2 = (int)(100.0 * pc / total + 0.5); m2 = m2 < 10 ? 10 : (m2 > 99 ? 99 : m2);
      int e2 = (int)(100.0 * pd / total / 4.0 + 0.5); e2 = e2 > 5 ? 5 : e2;
      float B = (float)m1 * 100.f;
      for (int i = 0; i < e1; i++) B *= 10.f;
      int n = m2;
      for (int i = 0; i < e2; i++) n *= 10;
      sh[0] = B;
      sh[1] = __int_as_float(n);
    }
    __syncthreads();
    float B = sh[0];
    int n = __float_as_int(sh[1]);
    for (int i = threadIdx.x; i < n; i += NTHR) P.out[i] = B;
  }
#endif
}

extern "C" void kernel_launch(void* const* d_in, const int* in_sizes, int n_in, void* d_out, int out_size, void* d_ws,
                              size_t ws_size, hipStream_t stream) {
  static int grid_blocks = 0;
  if (!grid_blocks) {
    int dev = 0, cus = 0, per_cu = 0;
    hipGetDevice(&dev);
    hipDeviceGetAttribute(&cus, hipDeviceAttributeMultiprocessorCount, dev);
    hipOccupancyMaxActiveBlocksPerMultiprocessor(&per_cu, mega_kernel, NTHR, 0);
    if (per_cu < 1) per_cu = 1;
    if (per_cu > 2) per_cu = 2;
    grid_blocks = cus * per_cu;
  }
  if (ws_size < WS_TOTAL) fprintf(stderr, "workspace too small: %zu < %zu\n", ws_size, (size_t)WS_TOTAL);
  Params p{};
  for (int i = 0; i < 32; i++) p.in[i] = (const float*)d_in[i];
  p.out = (float*)d_out;
  p.ws = (char*)d_ws;
  hipMemsetAsync((char*)d_ws + OFF_BAR, 0, 16384, stream);
  void* args[] = {&p};
  hipError_t e = hipLaunchCooperativeKernel((void*)mega_kernel, dim3(grid_blocks), dim3(NTHR), args, 0, stream);
  if (e != hipSuccess) fprintf(stderr, "cooperative launch failed: %s (grid %d)\n", hipGetErrorString(e), grid_blocks);
}
```

```cpp
#define PEER_ALIGN 1
#include <hip/hip_runtime.h>
#include <hip/hip_cooperative_groups.h>
#include <cstdio>
namespace cg = cooperative_groups;

typedef unsigned short u16;
using bf16x8 = __attribute__((ext_vector_type(8))) short;
using f32x4 = __attribute__((ext_vector_type(4))) float;
using u32x4 = __attribute__((ext_vector_type(4))) unsigned;

#define NTOK 16384
#define EPSF 1e-6f
#define NTHR 256

constexpr size_t OFF_WINT = 0;
constexpr size_t OFF_WOUTT = OFF_WINT + 4ull * 2816 * 1024 * 2;
constexpr size_t OFF_WQT = OFF_WOUTT + 4ull * 1024 * 1024 * 2;
constexpr size_t OFF_WGT = OFF_WQT + 4ull * 2048 * 1024 * 2;
constexpr size_t OFF_KEYS = OFF_WGT + 4ull * 256 * 256 * 2;
constexpr size_t OFF_UB = OFF_KEYS + 4ull * 2 * 128 * 128 * 2;
constexpr size_t OFF_VB = OFF_UB + 134217728ull;
constexpr size_t OFF_MOD = OFF_VB + 134217728ull;
constexpr size_t OFF_LB = OFF_MOD + 786432;
constexpr size_t OFF_S5A = OFF_LB + 8192;
constexpr size_t OFF_S5BB = OFF_S5A + 32768;
constexpr size_t OFF_SSQ = OFF_S5BB + 524288;
constexpr size_t OFF_XRES = OFF_SSQ + 1048576;
constexpr size_t OFF_HBUF = OFF_XRES + 67108864;
constexpr size_t OFF_PBUF = OFF_HBUF + 33554432;
constexpr size_t OFF_YBUF = OFF_PBUF + 184549376;
constexpr size_t OFF_QBUF = OFF_YBUF + 33554432;
constexpr size_t OFF_STOP = OFF_QBUF + 67108864;
constexpr size_t OFF_OBUF = OFF_STOP + 16777216;
constexpr size_t OFF_QG = OFF_OBUF + 33554432;
constexpr size_t OFF_SLOC = OFF_QG + 16777216;
constexpr size_t OFF_ST = OFF_SLOC + 67108864;
constexpr size_t OFF_DEC = OFF_ST + 33554432;
constexpr size_t OFF_S5E = OFF_DEC + 524288;
constexpr size_t OFF_S5XS = OFF_S5E + 2097152;
constexpr size_t OFF_ZBUF = OFF_S5XS + 2097152;
constexpr size_t OFF_HLOC = OFF_ZBUF + 8388608;
constexpr size_t OFF_PCUM = OFF_HLOC + 16777216;
constexpr size_t OFF_HST = OFF_PCUM + 16777216;
constexpr size_t OFF_BAR = OFF_HST + 262144;
constexpr size_t OFF_SMALL = OFF_BAR + 16384;
constexpr int SM_GMIX = 0, SM_CRE = SM_GMIX + 4096, SM_CIM = SM_CRE + 65536, SM_S5D = SM_CIM + 65536, SM_BGLU = SM_S5D + 1024,
              SM_CONVW = SM_BGLU + 1024, SM_CONVB = SM_CONVW + 4096, SM_WA = SM_CONVB + 1024, SM_BA = SM_WA + 65536,
              SM_WX = SM_BA + 1024, SM_BX = SM_WX + 65536, SM_LAM = SM_BX + 1024, SM_GFFN = SM_LAM + 1024,
              SM_GFINAL = SM_GFFN + 4096, SM_TOTAL = SM_GFINAL + 1024;
constexpr size_t WS_TOTAL = OFF_SMALL + (size_t)SM_TOTAL * 4;
#define SMALLP(ws, off) ((const float*)((ws) + OFF_SMALL) + (off))
static_assert(WS_TOTAL <= (1ull << 30), "workspace too large");

struct Params {
  const float* in[32];
  float* out;
  char* ws;
};

enum { I_X = 0, I_C, I_WMOD, I_BMOD, I_GMIX, I_WIN, I_LBL, I_S5ARE, I_S5AIM, I_S5BRE, I_S5BIM, I_S5CRE, I_S5CIM,
       I_S5LOGDT, I_S5D, I_S5WGLU, I_S5BGLU, I_CONVW, I_CONVB, I_WA, I_BA, I_WX, I_BX, I_LAM, I_GBR, I_WOUT,
       I_GFFN, I_WQ, I_KEYS, I_U, I_V, I_GFINAL };

typedef __attribute__((address_space(1))) char gchar;
__device__ __forceinline__ gchar* ows(const Params& P) {
  gchar* w = (gchar*)P.ws;
  asm volatile("" : "+s"(w));
  return w;
}
__device__ __forceinline__ int otid() {
  int t = threadIdx.x;
  asm volatile("" : "+v"(t));
  return t;
}
__device__ __forceinline__ u16 f2bf(float f) {
  unsigned u = __float_as_uint(f);
  u += 0x7fffu + ((u >> 16) & 1u);
  return (u16)(u >> 16);
}
__device__ __forceinline__ float bf2f(u16 h) { return __uint_as_float(((unsigned)h) << 16); }
__device__ __forceinline__ unsigned pack2(float a, float b) { return (unsigned)f2bf(a) | ((unsigned)f2bf(b) << 16); }
__device__ __forceinline__ float bflo(unsigned w) { return __uint_as_float(w << 16); }
__device__ __forceinline__ float bfhi(unsigned w) { return __uint_as_float(w & 0xffff0000u); }
__device__ __forceinline__ float sigmoidf_(float x) { return 1.f / (1.f + __expf(-x)); }
__device__ __forceinline__ float siluf_(float x) { return x * sigmoidf_(x); }
__device__ __forceinline__ float geluf_(float x) {
  float u = 0.7978845608028654f * (x + 0.044715f * x * x * x);
  float t = __expf(2.f * u);
  float th = 1.f - 2.f / (t + 1.f);
  return 0.5f * x * (1.f + th);
}
template <int CTRL>
__device__ __forceinline__ float dpp_mov(float v) {
  return __int_as_float(__builtin_amdgcn_update_dpp(0, __float_as_int(v), CTRL, 0xF, 0xF, false));
}
__device__ __forceinline__ float row_sum16(float v) {
  v += dpp_mov<0xB1>(v);
  v += dpp_mov<0x4E>(v);
  v += dpp_mov<0x141>(v);
  v += dpp_mov<0x140>(v);
  return v;
}
__device__ __forceinline__ float rdlane(float v, int l) {
  return __int_as_float(__builtin_amdgcn_readlane(__float_as_int(v), l));
}
__device__ __forceinline__ float wave_sum(float v) {
  v = row_sum16(v);
  return (rdlane(v, 0) + rdlane(v, 16)) + (rdlane(v, 32) + rdlane(v, 48));
}


#define XB_TMO      128
#define XB_XCNT(j)  (256  + 64 * (j))
#define XB_XSUB(j)  (1280 + 64 * (j))
#define XB_XGEN(j)  (2304 + 64 * (j))
#define XB_TOP      3328
#define XB_TOPGEN   3392
#define XCD_BAR_WORDS 3456
#define XB_SPIN_CAP (1u << 18)
#define LAS __attribute__((address_space(3)))
__device__ __forceinline__ unsigned xb_ld(unsigned* p) { return __hip_atomic_load(p, __ATOMIC_RELAXED, __HIP_MEMORY_SCOPE_AGENT); }
__device__ __forceinline__ unsigned xb_add(unsigned* p, unsigned v) { return __hip_atomic_fetch_add(p, v, __ATOMIC_RELAXED, __HIP_MEMORY_SCOPE_AGENT); }
__device__ __forceinline__ unsigned xb_xcc_id() { return (unsigned)__builtin_amdgcn_s_getreg((3 << 11) | 20) & 0xFu; }
#define XB_SPIN(cond, bar) do { unsigned _sp = 0; while (cond) { __builtin_amdgcn_s_sleep(1); \
    if ((++_sp & 255u) == 0u) { if (xb_ld(&(bar)[XB_TMO])) break; if (_sp > XB_SPIN_CAP) { atomicAdd(&(bar)[XB_TMO], 1u); break; } } } } while (0)
struct XcdBarrier { unsigned* bar; unsigned x; volatile LAS unsigned* st; };
__device__ __forceinline__ XcdBarrier xcd_barrier_post(unsigned* bar, volatile LAS unsigned* st) {
  XcdBarrier b; b.bar = bar; b.x = xb_xcc_id(); b.st = st;
  if (threadIdx.x == 0) (void)xb_add(&bar[XB_XCNT(b.x)], 1u);
  return b;
}
__device__ __forceinline__ void xcd_barrier_complete(unsigned* bar, unsigned x, unsigned& nloc, unsigned& nx) {
  const unsigned G = gridDim.x * gridDim.y * gridDim.z;
  unsigned sum, cnt, mine, sp = 0u;
  for (;;) {
    sum = 0u; cnt = 0u; mine = 0u;
#pragma unroll
    for (unsigned j = 0; j < 16; ++j) { const unsigned c = xb_ld(&bar[XB_XCNT(j)]); sum += c; cnt += (c > 0u) ? 1u : 0u; mine = (j == x) ? c : mine; }
    if (sum == G) break;
    __builtin_amdgcn_s_sleep(1);
    if ((++sp & 255u) == 0u) { if (xb_ld(&bar[XB_TMO])) break; if (sp > XB_SPIN_CAP) { atomicAdd(&bar[XB_TMO], 1u); break; } }
  }
  nloc = mine > 0u ? mine : 1u; nx = cnt > 0u ? cnt : 1u;
}
__device__ __forceinline__ void xcd_barrier(const XcdBarrier& b) {
  asm volatile("s_waitcnt vmcnt(0)" ::: "memory");
  __syncthreads();
  if (threadIdx.x == 0) {
    unsigned* bar = b.bar;
    __builtin_amdgcn_s_waitcnt(0);
    unsigned nloc = b.st[0], nx = b.st[1];
    if (nloc == 0u) { xcd_barrier_complete(bar, b.x, nloc, nx); b.st[0] = nloc; b.st[1] = nx; }
    const unsigned old = xb_add(&bar[XB_XSUB(b.x)], 1u);
    const unsigned gen = old / nloc;
    if (old + 1u == (gen + 1u) * nloc) {
      __builtin_amdgcn_fence(__ATOMIC_RELEASE, "agent");
      asm volatile("s_waitcnt vmcnt(0)" ::: "memory");
      const unsigned og = xb_add(&bar[XB_TOP], 1u);
      const unsigned tg = og / nx;
      if (og + 1u == (tg + 1u) * nx) xb_add(&bar[XB_TOPGEN], 1u);
      else XB_SPIN(xb_ld(&bar[XB_TOPGEN]) == tg, bar);
      __builtin_amdgcn_fence(__ATOMIC_ACQUIRE, "agent");
      xb_add(&bar[XB_XGEN(b.x)], 1u);
      asm volatile("s_waitcnt vmcnt(0)" ::: "memory");
    } else {
      XB_SPIN(xb_ld(&bar[XB_XGEN(b.x)]) == gen, bar);
      __builtin_amdgcn_fence(__ATOMIC_ACQUIRE, "agent");
      asm volatile("s_waitcnt vmcnt(0)" ::: "memory");
    }
  }
  __syncthreads();
}

__device__ __forceinline__ void xcd_barrier_exec(const XcdBarrier& b) {
  __syncthreads();
  if (threadIdx.x == 0) {
    unsigned* bar = b.bar;
    unsigned nloc = b.st[0], nx = b.st[1];
    if (nloc == 0u) { xcd_barrier_complete(bar, b.x, nloc, nx); b.st[0] = nloc; b.st[1] = nx; }
    const unsigned old = xb_add(&bar[XB_XSUB(b.x)], 1u);
    const unsigned gen = old / nloc;
    if (old + 1u == (gen + 1u) * nloc) {
      const unsigned og = xb_add(&bar[XB_TOP], 1u);
      const unsigned tg = og / nx;
      if (og + 1u == (tg + 1u) * nx) xb_add(&bar[XB_TOPGEN], 1u);
      else XB_SPIN(xb_ld(&bar[XB_TOPGEN]) == tg, bar);
      xb_add(&bar[XB_XGEN(b.x)], 1u);
    } else {
      XB_SPIN(xb_ld(&bar[XB_XGEN(b.x)]) == gen, bar);
    }
  }
  __syncthreads();
}

template <int BM, class KH, class EP>
__device__ __forceinline__ void gemm_tile(const u16* __restrict__ A, int lda, const u16* __restrict__ Bt, int ldb,
                                          int K, char* smem, KH&& kh, EP&& ep) {
  constexpr int MT = BM / 32;
  constexpr int NA = BM * 8 / NTHR;
  u16* As = (u16*)smem;
  u16* Bs = As + BM * 72;
  const int tid = otid(), lane = tid & 63, wid = tid >> 6, fr = lane & 15, fq = lane >> 4, wr = wid >> 1,
            wc = wid & 1;
  u32x4 ra0[NA], rb0[4], ra1[NA], rb1[4];
  f32x4 acc[MT][4];
#pragma unroll
  for (int m = 0; m < MT; m++)
#pragma unroll
    for (int n = 0; n < 4; n++) acc[m][n] = f32x4{0.f, 0.f, 0.f, 0.f};
  const int nk = K >> 6;
#define GT_LOAD(RA, RB, K0)                                                        \
  {                                                                                \
    _Pragma("unroll") for (int i = 0; i < NA; i++) {                               \
      int q = tid + i * NTHR, r = q >> 3, kc = q & 7;                              \
      RA[i] = *(const u32x4*)(A + (size_t)r * lda + (K0) + kc * 8);                \
    }                                                                              \
    _Pragma("unroll") for (int i = 0; i < 4; i++) {                                \
      int q = tid + i * NTHR, r = q >> 3, kc = q & 7;                              \
      RB[i] = *(const u32x4*)(Bt + (size_t)r * ldb + (K0) + kc * 8);               \
    }                                                                              \
  }
#define GT_STEP(RA, RB, KT)                                                        \
  {                                                                                \
    __syncthreads();                                                               \
    _Pragma("unroll") for (int i = 0; i < NA; i++) {                               \
      int q = tid + i * NTHR, r = q >> 3, kc = q & 7;                              \
      *(u32x4*)(As + r * 72 + kc * 8) = RA[i];                                     \
    }                                                                              \
    _Pragma("unroll") for (int i = 0; i < 4; i++) {                                \
      int q = tid + i * NTHR, r = q >> 3, kc = q & 7;                              \
      *(u32x4*)(Bs + r * 72 + kc * 8) = RB[i];                                     \
    }                                                                              \
    __syncthreads();                                                               \
    if ((KT) + 2 < nk) GT_LOAD(RA, RB, ((KT) + 2) << 6)                            \
    _Pragma("unroll") for (int ks = 0; ks < 2; ks++) {                             \
      bf16x8 af[MT], bfr[4];                                                       \
      _Pragma("unroll") for (int m = 0; m < MT; m++)                               \
        af[m] = *(const bf16x8*)(As + (wr * (BM / 2) + m * 16 + fr) * 72 + ks * 32 + fq * 8); \
      _Pragma("unroll") for (int n = 0; n < 4; n++)                                \
        bfr[n] = *(const bf16x8*)(Bs + (wc * 64 + n * 16 + fr) * 72 + ks * 32 + fq * 8);      \
      _Pragma("unroll") for (int m = 0; m < MT; m++)                               \
        _Pragma("unroll") for (int n = 0; n < 4; n++)                              \
          acc[m][n] = __builtin_amdgcn_mfma_f32_16x16x32_bf16(af[m], bfr[n], acc[m][n], 0, 0, 0); \
    }                                                                              \
    kh((KT), acc);                                                                 \
  }
  GT_LOAD(ra0, rb0, 0)
  if (nk > 1) GT_LOAD(ra1, rb1, 64)
  for (int kt = 0; kt < nk; kt += 2) {
    GT_STEP(ra0, rb0, kt)
    if (kt + 1 < nk) GT_STEP(ra1, rb1, kt + 1)
  }
#undef GT_LOAD
#undef GT_STEP
  ep(acc);
}

template <class KH, class EP>
__device__ __forceinline__ void gemm_tile256(const u16* __restrict__ A, int lda, const u16* __restrict__ Bt, int ldb,
                                             int K, char* smem, KH&& kh, EP&& ep) {
  u16* As = (u16*)smem;
  u16* Bs = As + 256 * 72;
  const int tid = otid(), lane = tid & 63, wid = tid >> 6, fr = lane & 15, fq = lane >> 4, wr = wid >> 1,
            wc = wid & 1;
  u32x4 ra[8], rb[4];
  f32x4 acc[8][4];
#pragma unroll
  for (int m = 0; m < 8; m++)
#pragma unroll
    for (int n = 0; n < 4; n++) acc[m][n] = f32x4{0.f, 0.f, 0.f, 0.f};
  const int nk = K >> 6;
#pragma unroll
  for (int i = 0; i < 8; i++) {
    int q = tid + i * NTHR, r = q >> 3, kc = q & 7;
    ra[i] = *(const u32x4*)(A + (size_t)r * lda + kc * 8);
  }
#pragma unroll
  for (int i = 0; i < 4; i++) {
    int q = tid + i * NTHR, r = q >> 3, kc = q & 7;
    rb[i] = *(const u32x4*)(Bt + (size_t)r * ldb + kc * 8);
  }
  for (int kt = 0; kt < nk; kt++) {
    __syncthreads();
#pragma unroll
    for (int i = 0; i < 8; i++) {
      int q = tid + i * NTHR, r = q >> 3, kc = q & 7;
      *(u32x4*)(As + r * 72 + kc * 8) = ra[i];
    }
#pragma unroll
    for (int i = 0; i < 4; i++) {
      int q = tid + i * NTHR, r = q >> 3, kc = q & 7;
      *(u32x4*)(Bs + r * 72 + kc * 8) = rb[i];
    }
    __syncthreads();
    if (kt + 1 < nk) {
      const int k0 = (kt + 1) << 6;
#pragma unroll
      for (int i = 0; i < 8; i++) {
        int q = tid + i * NTHR, r = q >> 3, kc = q & 7;
        ra[i] = *(const u32x4*)(A + (size_t)r * lda + k0 + kc * 8);
      }
#pragma unroll
      for (int i = 0; i < 4; i++) {
        int q = tid + i * NTHR, r = q >> 3, kc = q & 7;
        rb[i] = *(const u32x4*)(Bt + (size_t)r * ldb + k0 + kc * 8);
      }
    }
#pragma unroll
    for (int ks = 0; ks < 2; ks++) {
      bf16x8 bfr[4];
#pragma unroll
      for (int n = 0; n < 4; n++) bfr[n] = *(const bf16x8*)(Bs + (wc * 64 + n * 16 + fr) * 72 + ks * 32 + fq * 8);
#pragma unroll
      for (int mh = 0; mh < 2; mh++) {
        bf16x8 af[4];
#pragma unroll
        for (int m = 0; m < 4; m++)
          af[m] = *(const bf16x8*)(As + (wr * 128 + (mh * 4 + m) * 16 + fr) * 72 + ks * 32 + fq * 8);
#pragma unroll
        for (int m = 0; m < 4; m++)
#pragma unroll
          for (int n = 0; n < 4; n++)
            acc[mh * 4 + m][n] = __builtin_amdgcn_mfma_f32_16x16x32_bf16(af[m], bfr[n], acc[mh * 4 + m][n], 0, 0, 0);
      }
    }
    kh(kt, acc);
  }
  ep(acc);
}

struct NoHook {
  template <class T>
  __device__ __forceinline__ void operator()(int, T&) const {}
};

__device__ __forceinline__ void transpose_tile(const float* __restrict__ src, int ld_src, u16* __restrict__ dst, int ld_dst, int k0,
                               int n0, const float* __restrict__ rowscale, char* smem) {
  float(*T)[65] = (float(*)[65])smem;
  const int tid = otid();
  __syncthreads();
#pragma unroll
  for (int i = 0; i < 16; i++) {
    int r = (tid >> 6) + 4 * i;
    float v = src[(size_t)(k0 + r) * ld_src + n0 + (tid & 63)];
    if (rowscale) v *= rowscale[k0 + r];
    T[r][tid & 63] = v;
  }
  __syncthreads();
#pragma unroll
  for (int i = 0; i < 16; i++) {
    int n = (tid >> 6) + 4 * i;
    dst[(size_t)(n0 + n) * ld_dst + k0 + (tid & 63)] = f2bf(T[tid & 63][n]);
  }
}

constexpr int NP_UV = 16384;
constexpr int NP_TIN = 2816;
constexpr int NP_TOUT = 1024;
constexpr int NP_TQ = 2048;
constexpr int NP_TG = 64;
constexpr int NP_MOD = 384;
constexpr int NP_LB = 1;
constexpr int NP_S5 = 4;
constexpr int NP_KEYS = 8;
constexpr int NP_SSQ = 16;
constexpr int NP_SM = 14;
constexpr int NP_TOTAL = NP_UV + NP_TIN + NP_TOUT + NP_TQ + NP_TG + NP_MOD + NP_LB + NP_S5 + NP_KEYS + NP_SSQ + NP_SM;

__device__ __forceinline__ void phase_prep(const Params& P, char* smem) {
  const int tid = otid();
  gchar* ws = ows(P);
  for (int item = blockIdx.x; item < NP_TOTAL; item += gridDim.x) {
    int idx = item;
    if (idx < NP_UV) {
      const float* src = (idx < 8192) ? P.in[I_U] : P.in[I_V];
      u16* dst = (u16*)(ws + ((idx < 8192) ? OFF_UB : OFF_VB));
      size_t base = (size_t)(idx & 8191) * 8192;
#pragma unroll
      for (int it = 0; it < 4; it++) {
        size_t e = base + (size_t)(it * NTHR + tid) * 8;
        float4 a = *(const float4*)(src + e);
        float4 b = *(const float4*)(src + e + 4);
        uint4 o;
        o.x = pack2(a.x, a.y); o.y = pack2(a.z, a.w); o.z = pack2(b.x, b.y); o.w = pack2(b.z, b.w);
        *(uint4*)(dst + e) = o;
      }
      continue;
    }
    idx -= NP_UV;
    if (idx < NP_TIN) {
      int l = idx / 704, r = idx % 704, kt = r / 44, nt = r % 44;
      transpose_tile(P.in[I_WIN] + (size_t)l * 1024 * 2816, 2816, (u16*)(ws + OFF_WINT) + (size_t)l * 2816 * 1024, 1024,
                     kt * 64, nt * 64, nullptr, smem);
      continue;
    }
    idx -= NP_TIN;
    if (idx < NP_TOUT) {
      int l = idx >> 8, r = idx & 255, kt = r >> 4, nt = r & 15;
      transpose_tile(P.in[I_WOUT] + (size_t)l * 1048576, 1024, (u16*)(ws + OFF_WOUTT) + (size_t)l * 1048576, 1024,
                     kt * 64, nt * 64, P.in[I_GBR] + l * 1024, smem);
      continue;
    }
    idx -= NP_TOUT;
    if (idx < NP_TQ) {
      int l = idx >> 9, r = idx & 511, kt = r >> 5, nt = r & 31;
      transpose_tile(P.in[I_WQ] + (size_t)l * 1024 * 2048, 2048, (u16*)(ws + OFF_WQT) + (size_t)l * 2048 * 1024, 1024,
                     kt * 64, nt * 64, nullptr, smem);
      continue;
    }
    idx -= NP_TQ;
    if (idx < NP_TG) {
      int l = idx >> 4, r = idx & 15, kt = r >> 2, nt = r & 3;
      transpose_tile(P.in[I_S5WGLU] + (size_t)l * 65536, 256, (u16*)(ws + OFF_WGT) + (size_t)l * 65536, 256, kt * 64,
                     nt * 64, nullptr, smem);
      continue;
    }
    idx -= NP_TG;
    if (idx < NP_MOD) {
      int l = idx / 96, n0 = (idx % 96) * 64;
      float* cs = (float*)smem;
      float* red = cs + 8192;
      __syncthreads();
      for (int i = tid; i < 8192; i += NTHR) cs[i] = siluf_(P.in[I_C][i]);
      __syncthreads();
      int j = tid & 63, kq = tid >> 6;
      float a[8];
#pragma unroll
      for (int b = 0; b < 8; b++) a[b] = 0.f;
      const float* w = P.in[I_WMOD] + (size_t)l * 1024 * 6144 + n0 + j;
      for (int k0 = kq * 256; k0 < kq * 256 + 256; k0 += 16) {
        float wv[16];
#pragma unroll
        for (int u = 0; u < 16; u++) wv[u] = w[(size_t)(k0 + u) * 6144];
#pragma unroll
        for (int u = 0; u < 16; u++)
#pragma unroll
          for (int b = 0; b < 8; b++) a[b] += cs[b * 1024 + k0 + u] * wv[u];
      }
#pragma unroll
      for (int b = 0; b < 8; b++) red[(kq * 8 + b) * 64 + j] = a[b];
      __syncthreads();
      for (int o = tid; o < 512; o += NTHR) {
        int b = o >> 6, jj = o & 63;
        float s = red[(0 * 8 + b) * 64 + jj] + red[(1 * 8 + b) * 64 + jj] + red[(2 * 8 + b) * 64 + jj] +
                  red[(3 * 8 + b) * 64 + jj];
        s += P.in[I_BMOD][l * 6144 + n0 + jj];
        ((float*)(ws + OFF_MOD))[(size_t)(l * 8 + b) * 6144 + n0 + jj] = s;
      }
      continue;
    }
    idx -= NP_MOD;
    if (idx < NP_LB) {
      float* LB = (float*)(ws + OFF_LB);
      for (int ch = tid; ch < 512; ch += NTHR) {
        float v0 = P.in[I_LBL][ch], v1 = P.in[I_LBL][512 + ch], v2 = P.in[I_LBL][1024 + ch], v3 = P.in[I_LBL][1536 + ch];
        float m = fmaxf(fmaxf(v0, v1), fmaxf(v2, v3));
        float e0 = expf(v0 - m), e1 = expf(v1 - m), e2 = expf(v2 - m), e3 = expf(v3 - m);
        float inv = 1.f / (e0 + e1 + e2 + e3);
        LB[ch] = 0.f;
        LB[512 + ch] = e1 * inv;
        LB[1024 + ch] = (e1 + e2) * inv;
        LB[1536 + ch] = (e1 + e2 + e3) * inv;
      }
      continue;
    }
    idx -= NP_LB;
    if (idx < NP_S5) {
      int l = idx;
      float* SA = (float*)(ws + OFF_S5A);
      float* SB = (float*)(ws + OFF_S5BB);
      for (int gp = tid; gp < 1024; gp += NTHR) {
        int g = gp >> 6;
        float lre = fminf(P.in[I_S5ARE][l * 1024 + gp], -1e-4f);
        float lim = P.in[I_S5AIM][l * 1024 + gp];
        float dt = expf(P.in[I_S5LOGDT][l * 16 + g]);
        float mag = expf(lre * dt);
        float abr = mag * cosf(lim * dt), abi = mag * sinf(lim * dt);
        float den = lre * lre + lim * lim;
        float nr = abr - 1.f;
        float zr = (nr * lre + abi * lim) / den;
        float zi = (abi * lre - nr * lim) / den;
        SA[(l * 1024 + gp) * 2 + 0] = abr;
        SA[(l * 1024 + gp) * 2 + 1] = abi;
        const float* br = P.in[I_S5BRE] + (size_t)(l * 1024 + gp) * 16;
        const float* bi = P.in[I_S5BIM] + (size_t)(l * 1024 + gp) * 16;
        float* o = SB + (size_t)(l * 1024 + gp) * 32;
#pragma unroll
        for (int c = 0; c < 16; c++) {
          o[c] = zr * br[c] - zi * bi[c];
          o[16 + c] = zr * bi[c] + zi * br[c];
        }
      }
      continue;
    }
    idx -= NP_S5;
    if (idx < NP_KEYS) {
      u16* KB = (u16*)(ws + OFF_KEYS);
#pragma unroll 16
      for (int i = 0; i < 64; i++) {
        int e = idx * 16384 + i * NTHR + tid;
        KB[e] = f2bf(P.in[I_KEYS][e]);
      }
      continue;
    }
    idx -= NP_KEYS;
    if (idx < NP_SSQ) {
      float* SS = (float*)(ws + OFF_SSQ);
      for (int i = 0; i < 64; i++) SS[idx * 16384 + i * NTHR + tid] = 0.f;
      continue;
    }
    idx -= NP_SSQ;
    {
      const float* src; int off, n;
      switch (idx) {
        case 0: src = P.in[I_GMIX]; off = SM_GMIX; n = 4096; break;
        case 1: src = P.in[I_S5CRE]; off = SM_CRE; n = 65536; break;
        case 2: src = P.in[I_S5CIM]; off = SM_CIM; n = 65536; break;
        case 3: src = P.in[I_S5D]; off = SM_S5D; n = 1024; break;
        case 4: src = P.in[I_S5BGLU]; off = SM_BGLU; n = 1024; break;
        case 5: src = P.in[I_CONVW]; off = SM_CONVW; n = 4096; break;
        case 6: src = P.in[I_CONVB]; off = SM_CONVB; n = 1024; break;
        case 7: src = P.in[I_WA]; off = SM_WA; n = 65536; break;
        case 8: src = P.in[I_BA]; off = SM_BA; n = 1024; break;
        case 9: src = P.in[I_WX]; off = SM_WX; n = 65536; break;
        case 10: src = P.in[I_BX]; off = SM_BX; n = 1024; break;
        case 11: src = P.in[I_LAM]; off = SM_LAM; n = 1024; break;
        case 12: src = P.in[I_GFFN]; off = SM_GFFN; n = 4096; break;
        default: src = P.in[I_GFINAL]; off = SM_GFINAL; n = 1024; break;
      }
      float* dst = (float*)(ws + OFF_SMALL) + off;
      for (int i0 = tid; i0 < n; i0 += NTHR * 16) {
        float tmp[16];
#pragma unroll
        for (int u = 0; u < 16; u++) tmp[u] = (i0 + u * NTHR < n) ? src[i0 + u * NTHR] : 0.f;
#pragma unroll
        for (int u = 0; u < 16; u++)
          if (i0 + u * NTHR < n) dst[i0 + u * NTHR] = tmp[u];
      }
    }
  }
}

__device__ __forceinline__ void phase_norm(const float* __restrict__ xsrc, const float* __restrict__ g, const float* __restrict__ modl,
                           int sh_off, int sc_off, u16* __restrict__ hb) {
  const int lane = otid() & 63;
  const int wave = (blockIdx.x * NTHR + otid()) >> 6, nw = gridDim.x * 4;
  for (int t = wave; t < NTOK; t += nw) {
    const float4* xr = (const float4*)(xsrc + (size_t)t * 1024);
    float4 v[4];
    float ss = 0.f;
#pragma unroll
    for (int i = 0; i < 4; i++) {
      v[i] = xr[lane + 64 * i];
      ss += v[i].x * v[i].x + v[i].y * v[i].y + v[i].z * v[i].z + v[i].w * v[i].w;
    }
    ss = wave_sum(ss);
    float rstd = rsqrtf(ss * (1.f / 1024.f) + EPSF);
    const float* mb = modl + (size_t)(t >> 11) * 6144;
#pragma unroll
    for (int i = 0; i < 4; i++) {
      int col = (lane + 64 * i) * 4;
      float4 g4 = *(const float4*)(g + col);
      float4 sc = *(const float4*)(mb + sc_off + col);
      float4 sh = *(const float4*)(mb + sh_off + col);
      float h0 = v[i].x * rstd * g4.x * (1.f + sc.x) + sh.x;
      float h1 = v[i].y * rstd * g4.y * (1.f + sc.y) + sh.y;
      float h2 = v[i].z * rstd * g4.z * (1.f + sc.z) + sh.z;
      float h3 = v[i].w * rstd * g4.w * (1.f + sc.w) + sh.w;
      uint2 o;
      o.x = pack2(h0, h1);
      o.y = pack2(h2, h3);
      *(uint2*)(hb + (size_t)t * 1024 + col) = o;
    }
  }
}

__device__ __forceinline__ void phase_gemm_in(const Params& P, int l, char* smem) {
  gchar* ws = ows(P);
  const u16* HB = (const u16*)(ws + OFF_HBUF);
  const u16* W = (const u16*)(ws + OFF_WINT) + (size_t)l * 2816 * 1024;
  float* PB = (float*)(ws + OFF_PBUF);
  const int lane = otid() & 63, wid = otid() >> 6, fr = lane & 15, fq = lane >> 4, wr = wid >> 1, wc = wid & 1;
  for (int tile = blockIdx.x; tile < 64 * 22; tile += gridDim.x) {
    int mt = tile / 22, nt = tile % 22;
    float* out = PB + (size_t)(mt * 256) * 2816 + nt * 128;
    gemm_tile256(HB + (size_t)mt * 256 * 1024, 1024, W + (size_t)nt * 128 * 1024, 1024, 1024, smem, NoHook(),
                 [&](f32x4(&acc)[8][4]) {
                   const int t_ = otid(), l_ = t_ & 63, w_ = t_ >> 6, fr = l_ & 15, fq = l_ >> 4, wr = w_ >> 1, wc = w_ & 1;
#pragma unroll
                   for (int m = 0; m < 8; m++)
#pragma unroll
                     for (int j = 0; j < 4; j++) {
                       float* rp = out + (size_t)(wr * 128 + m * 16 + fq * 4 + j) * 2816 + wc * 64 + fr;
#pragma unroll
                       for (int n = 0; n < 4; n++) rp[n * 16] = acc[m][n][j];
                     }
                 });
  }
}

__device__ __forceinline__ void hgrn_local(const Params& P, int l, int item, char* smem) {
  gchar* ws = ows(P);
  const int c = item & 31, h = (item >> 5) & 3, b = item >> 7;
  const int t0 = b * 2048 + c * 64;
  int tid = otid();
  asm volatile("" : "+v"(tid));
  const int d = tid & 127, half = tid >> 7;
  const float* pb = (const float*)(ws + OFF_PBUF) + (size_t)t0 * 2816;
  const int lane = tid & 63, w = tid >> 6, fr = lane & 15, fq = lane >> 4;
  const float lbv = ((const float*)(ws + OFF_LB))[l * 512 + h * 128 + d];
  u16* Aq = (u16*)smem;
  u16* BI = Aq + 64 * 136;
  u16* Sc = BI + 64 * 136;
  u16* vT = Sc + 64 * 72;
  float* anc = (float*)(vT + 128 * 72);
  u16* kdT = (u16*)smem;
  __syncthreads();
  float bb[32];
  unsigned kkp[16];
  {
    float run = 0.f;
#pragma unroll
    for (int i = 0; i < 32; i++) {
      int t = half * 32 + i;
      float fp = pb[(size_t)t * 2816 + 512 + h * 128 + d];
      float f = lbv + (1.f - lbv) * sigmoidf_(fp);
      run += logf(f);
      bb[i] = run;
      if (i & 1) kkp[i >> 1] |= ((unsigned)f2bf(1.f - f)) << 16;
      else kkp[i >> 1] = (unsigned)f2bf(1.f - f);
      if ((i & 15) == 15) __builtin_amdgcn_sched_barrier(0);
    }
  }
  if (half == 0) {
    anc[d] = 0.f;
    anc[128 + d] = bb[15];
    anc[256 + d] = bb[31];
  }
  __syncthreads();
  if (half == 1) {
    float off = anc[256 + d];
#pragma unroll
    for (int i = 0; i < 32; i++) bb[i] += off;
    anc[384 + d] = bb[15];
    anc[512 + d] = bb[31];
  }
  __syncthreads();
  const float b31 = anc[256 + d], b63 = anc[512 + d];
  {
    u16* QG = (u16*)(ws + OFF_QG);
    const float a_lo = half ? b31 : 0.f;
    const float a_hi = bb[15];
#pragma unroll
    for (int i = 0; i < 32; i++) {
      int t = half * 32 + i;
      float q = pb[(size_t)t * 2816 + h * 128 + d];
      float qa = siluf_(q);
      float anchor = (i < 16) ? a_lo : a_hi;
      Aq[t * 136 + d] = f2bf(qa * __expf(bb[i] - anchor));
      QG[(size_t)(t0 + t) * 512 + h * 128 + d] = f2bf(qa * __expf(bb[i]));
      if ((i & 15) == 15) __builtin_amdgcn_sched_barrier(0);
    }
#pragma unroll
    for (int grp = 0; grp < 4; grp++) {
      float vv[8];
#pragma unroll
      for (int e = 0; e < 8; e++) vv[e] = pb[(size_t)(half * 32 + grp * 8 + e) * 2816 + 1024 + h * 128 + d];
      uint4 o;
      o.x = pack2(vv[0], vv[1]); o.y = pack2(vv[2], vv[3]); o.z = pack2(vv[4], vv[5]); o.w = pack2(vv[6], vv[7]);
      *(uint4*)(vT + d * 72 + half * 32 + grp * 8) = o;
      __builtin_amdgcn_sched_barrier(0);
    }
  }
  for (int I = 0; I < 4; I++) {
    __syncthreads();
    const float rI = anc[I * 128 + d];
#pragma unroll
    for (int i = 0; i < 32; i++) {
      int s = half * 32 + i;
      if (s < 16 * (I + 1)) BI[s * 136 + d] = f2bf(((i & 1) ? bfhi(kkp[i >> 1]) : bflo(kkp[i >> 1])) * __expf(rI - bb[i]));
    }
    __syncthreads();
    if (w <= I) {
      f32x4 acc = f32x4{0.f, 0.f, 0.f, 0.f};
#pragma unroll
      for (int ks = 0; ks < 4; ks++) {
        bf16x8 a = *(const bf16x8*)(Aq + (16 * I + fr) * 136 + ks * 32 + fq * 8);
        bf16x8 bq = *(const bf16x8*)(BI + (16 * w + fr) * 136 + ks * 32 + fq * 8);
        acc = __builtin_amdgcn_mfma_f32_16x16x32_bf16(a, bq, acc, 0, 0, 0);
      }
#pragma unroll
      for (int j = 0; j < 4; j++) {
        float val = acc[j];
        if (w == I && fr > fq * 4 + j) val = 0.f;
        Sc[(16 * I + fq * 4 + j) * 72 + 16 * w + fr] = f2bf(val);
      }
    } else {
#pragma unroll
      for (int j = 0; j < 4; j++) Sc[(16 * I + fq * 4 + j) * 72 + 16 * w + fr] = 0;
    }
  }
  __syncthreads();
#pragma unroll
  for (int grp = 0; grp < 4; grp++) {
    float vv[8];
#pragma unroll
    for (int e = 0; e < 8; e++) vv[e] = ((e & 1) ? bfhi(kkp[(grp * 8 + e) >> 1]) : bflo(kkp[(grp * 8 + e) >> 1])) * __expf(b63 - bb[grp * 8 + e]);
    uint4 o;
    o.x = pack2(vv[0], vv[1]); o.y = pack2(vv[2], vv[3]); o.z = pack2(vv[4], vv[5]); o.w = pack2(vv[6], vv[7]);
    *(uint4*)(kdT + d * 72 + half * 32 + grp * 8) = o;
  }
  {
    f32x4 oacc[4][2];
#pragma unroll
    for (int m = 0; m < 4; m++)
#pragma unroll
      for (int n = 0; n < 2; n++) oacc[m][n] = f32x4{0.f, 0.f, 0.f, 0.f};
#pragma unroll
    for (int ks = 0; ks < 2; ks++) {
      bf16x8 a[4], bq[2];
#pragma unroll
      for (int m = 0; m < 4; m++) a[m] = *(const bf16x8*)(Sc + (m * 16 + fr) * 72 + ks * 32 + fq * 8);
#pragma unroll
      for (int n = 0; n < 2; n++) bq[n] = *(const bf16x8*)(vT + ((2 * w + n) * 16 + fr) * 72 + ks * 32 + fq * 8);
#pragma unroll
      for (int m = 0; m < 4; m++)
#pragma unroll
        for (int n = 0; n < 2; n++) oacc[m][n] = __builtin_amdgcn_mfma_f32_16x16x32_bf16(a[m], bq[n], oacc[m][n], 0, 0, 0);
    }
    float* OB = (float*)(ws + OFF_OBUF);
#pragma unroll
    for (int m = 0; m < 4; m++)
#pragma unroll
      for (int n = 0; n < 2; n++)
#pragma unroll
        for (int j = 0; j < 4; j++)
          OB[(size_t)(t0 + m * 16 + fq * 4 + j) * 512 + h * 128 + (2 * w + n) * 16 + fr] = oacc[m][n][j];
  }
  __syncthreads();
  {
    f32x4 sacc[2][8];
#pragma unroll
    for (int m = 0; m < 2; m++)
#pragma unroll
      for (int n = 0; n < 8; n++) sacc[m][n] = f32x4{0.f, 0.f, 0.f, 0.f};
#pragma unroll
    for (int ks = 0; ks < 2; ks++) {
      bf16x8 a[2];
#pragma unroll
      for (int m = 0; m < 2; m++) a[m] = *(const bf16x8*)(vT + ((2 * w + m) * 16 + fr) * 72 + ks * 32 + fq * 8);
#pragma unroll
      for (int n = 0; n < 8; n++) {
        bf16x8 bq = *(const bf16x8*)(kdT + (n * 16 + fr) * 72 + ks * 32 + fq * 8);
#pragma unroll
        for (int m = 0; m < 2; m++) sacc[m][n] = __builtin_amdgcn_mfma_f32_16x16x32_bf16(a[m], bq, sacc[m][n], 0, 0, 0);
      }
    }
    float* SL = (float*)(ws + OFF_SLOC) + (size_t)((b * 4 + h) * 32 + c) * 16384;
#pragma unroll
    for (int m = 0; m < 2; m++)
#pragma unroll
      for (int n = 0; n < 8; n++)
#pragma unroll
        for (int j = 0; j < 4; j++) SL[((2 * w + m) * 16 + fq * 4 + j) * 128 + n * 16 + fr] = sacc[m][n][j];
    if (half == 1) ((float*)(ws + OFF_DEC))[((b * 4 + h) * 32 + c) * 128 + d] = __expf(b63);
  }
}

__device__ __forceinline__ void hgrn_carry(const Params& P, int item) {
  gchar* ws = ows(P);
  const int bh = item >> 6, e = (item & 63) * 256 + otid(), d = e & 127;
  const float* SL = (const float*)(ws + OFF_SLOC);
  const float* DC = (const float*)(ws + OFF_DEC);
  u16* ST = (u16*)(ws + OFF_ST);
  float run = 0.f;
  float locv[32], decv[32];
#pragma unroll
  for (int c = 0; c < 32; c++) {
    locv[c] = SL[(size_t)(bh * 32 + c) * 16384 + e];
    decv[c] = DC[(bh * 32 + c) * 128 + d];
  }
#pragma unroll
  for (int c = 0; c < 32; c++) {
    ST[(size_t)(bh * 32 + c) * 16384 + e] = f2bf(run);
    run = run * decv[c] + locv[c];
  }
}

__device__ __forceinline__ void hgrn_final(const Params& P, int l, int item, char* smem, size_t ssq_off) {
  gchar* ws = ows(P);
  const int c = item & 31, h = (item >> 5) & 3, b = item >> 7;
  const int t0 = b * 2048 + c * 64;
  const int tid = otid(), lane = tid & 63, wid = tid >> 6, fr = lane & 15, fq = lane >> 4, wr = wid >> 1, wc = wid & 1;
  const u16* QG = (const u16*)(ws + OFF_QG) + (size_t)t0 * 512 + h * 128;
  const u16* ST = (const u16*)(ws + OFF_ST) + (size_t)((b * 4 + h) * 32 + c) * 16384;
  const float* OB = (const float*)(ws + OFF_OBUF) + (size_t)t0 * 512 + h * 128;
  float* tile = (float*)(smem + 27648);
  gemm_tile<64>(QG, 512, ST, 128, 128, smem, NoHook(), [&](f32x4(&acc)[2][4]) {
#pragma unroll
    for (int m = 0; m < 2; m++)
#pragma unroll
      for (int n = 0; n < 4; n++)
#pragma unroll
        for (int j = 0; j < 4; j++) {
          int r = wr * 32 + m * 16 + fq * 4 + j, cc = wc * 64 + n * 16 + fr;
          tile[r * 132 + cc] = acc[m][n][j] + OB[(size_t)r * 512 + cc];
        }
  });
  __syncthreads();
  const float* pb = (const float*)(ws + OFF_PBUF);
  u16* YB = (u16*)(ws + OFF_YBUF);
  float* SS = (float*)(ws + ssq_off);
#pragma unroll 4
  for (int rr = 0; rr < 16; rr++) {
    int r = wid * 16 + rr, t = t0 + r;
    float o0 = tile[r * 132 + lane], o1 = tile[r * 132 + 64 + lane];
    float ss = wave_sum(o0 * o0 + o1 * o1);
    float rstd = rsqrtf(ss * (1.f / 128.f) + EPSF);
    float g0 = pb[(size_t)t * 2816 + 1536 + h * 128 + lane], g1 = pb[(size_t)t * 2816 + 1536 + h * 128 + 64 + lane];
    float y0 = o0 * rstd * siluf_(g0), y1 = o1 * rstd * siluf_(g1);
    YB[(size_t)t * 1024 + h * 128 + lane] = f2bf(y0);
    YB[(size_t)t * 1024 + h * 128 + 64 + lane] = f2bf(y1);
    float s2 = wave_sum(y0 * y0 + y1 * y1);
    if (lane == 0) atomicAdd(&SS[t * 4 + 0], s2);
  }
}

template <bool FINAL>
__device__ __forceinline__ void s5_pass(const Params& P, int l, int item, char* smem) {
  gchar* ws = ows(P);
  const int cq = item & 7, g = (item >> 3) & 15, b = item >> 7;
  const int tid = otid(), lane = tid & 63, w = tid >> 6;
  const int c = cq * 4 + w;
  const int t0 = b * 2048 + c * 64;
  float* Cre = (float*)smem;
  float* Cim = Cre + 1024;
  float* ub = Cim + 1024 + w * 256;
  float2* xs = (float2*)(smem + 8192 + 4096) + w * (16 * 65);
  const float* pb = (const float*)(ws + OFF_PBUF);
  __syncthreads();
  if (FINAL) {
#pragma unroll
    for (int i = 0; i < 4; i++) {
      int idx = tid + i * NTHR, cc = idx >> 6, p = idx & 63;
      Cre[p * 16 + cc] = SMALLP(ws, SM_CRE)[(size_t)(l * 16 + g) * 1024 + idx];
      Cim[p * 16 + cc] = SMALLP(ws, SM_CIM)[(size_t)(l * 16 + g) * 1024 + idx];
    }
  }
  const float* SA = (const float*)(ws + OFF_S5A) + (size_t)((l * 16 + g) * 64 + lane) * 2;
  const float are = SA[0], aim = SA[1];
  float bbr[16], bbi[16];
  {
    const float4* SB = (const float4*)((const float*)(ws + OFF_S5BB) + (size_t)((l * 16 + g) * 64 + lane) * 32);
#pragma unroll
    for (int i = 0; i < 4; i++) {
      float4 v = SB[i];
      bbr[i * 4 + 0] = v.x; bbr[i * 4 + 1] = v.y; bbr[i * 4 + 2] = v.z; bbr[i * 4 + 3] = v.w;
      float4 u = SB[4 + i];
      bbi[i * 4 + 0] = u.x; bbi[i * 4 + 1] = u.y; bbi[i * 4 + 2] = u.z; bbi[i * 4 + 3] = u.w;
    }
  }
  float xr = 0.f, xi = 0.f;
  const size_t sidx = (size_t)((b * 16 + g) * 32 + c) * 64 + lane;
  if (FINAL) {
    float2 x0 = ((const float2*)(ws + OFF_S5XS))[sidx];
    xr = x0.x; xi = x0.y;
  }
  float4 uvn = *(const float4*)(pb + (size_t)(t0 + (lane >> 2)) * 2816 + 2048 + g * 16 + (lane & 3) * 4);
  for (int sub = 0; sub < 4; sub++) {
    __syncthreads();
    *(float4*)(ub + (lane >> 2) * 16 + (lane & 3) * 4) = uvn;
    __syncthreads();
    if (sub < 3)
      uvn = *(const float4*)(pb + (size_t)(t0 + (sub + 1) * 16 + (lane >> 2)) * 2816 + 2048 + g * 16 + (lane & 3) * 4);
#pragma unroll 4
    for (int tt = 0; tt < 16; tt++) {
      float br = 0.f, bi = 0.f;
#pragma unroll
      for (int q = 0; q < 4; q++) {
        float4 uv = *(const float4*)(ub + tt * 16 + q * 4);
        br += uv.x * bbr[q * 4 + 0] + uv.y * bbr[q * 4 + 1] + uv.z * bbr[q * 4 + 2] + uv.w * bbr[q * 4 + 3];
        bi += uv.x * bbi[q * 4 + 0] + uv.y * bbi[q * 4 + 1] + uv.z * bbi[q * 4 + 2] + uv.w * bbi[q * 4 + 3];
      }
      float nxr = are * xr - aim * xi + br;
      float nxi = are * xi + aim * xr + bi;
      xr = nxr; xi = nxi;
      if (FINAL) xs[tt * 65 + lane] = make_float2(xr, xi);
    }
    if (FINAL) {
      __syncthreads();
      int tt = lane >> 2, c4 = (lane & 3) * 4;
      float y0 = 0.f, y1 = 0.f, y2 = 0.f, y3 = 0.f;
#pragma unroll 8
      for (int p = 0; p < 64; p++) {
        float2 x = xs[tt * 65 + p];
        float4 cr = *(const float4*)(Cre + p * 16 + c4);
        float4 ci = *(const float4*)(Cim + p * 16 + c4);
        y0 += x.x * cr.x - x.y * ci.x;
        y1 += x.x * cr.y - x.y * ci.y;
        y2 += x.x * cr.z - x.y * ci.z;
        y3 += x.x * cr.w - x.y * ci.w;
      }
      float4 uv = *(const float4*)(ub + tt * 16 + c4);
      float4 dk = *(const float4*)(SMALLP(ws, SM_S5D) + l * 256 + g * 16 + c4);
      y0 = geluf_(y0 + dk.x * uv.x);
      y1 = geluf_(y1 + dk.y * uv.y);
      y2 = geluf_(y2 + dk.z * uv.z);
      y3 = geluf_(y3 + dk.w * uv.w);
      uint2 o;
      o.x = pack2(y0, y1);
      o.y = pack2(y2, y3);
      *(uint2*)((u16*)(ws + OFF_ZBUF) + (size_t)(t0 + sub * 16 + tt) * 256 + g * 16 + c4) = o;
    }
  }
  if (!FINAL) ((float2*)(ws + OFF_S5E))[sidx] = make_float2(xr, xi);
}

__device__ __forceinline__ void s5_carry(const Params& P, int l, int item) {
  gchar* ws = ows(P);
  const int idx = item * NTHR + otid(), p = idx & 63, g = (idx >> 6) & 15, b = idx >> 10;
  const float* SA = (const float*)(ws + OFF_S5A) + (size_t)((l * 16 + g) * 64 + p) * 2;
  float ar = SA[0], ai = SA[1];
#pragma unroll
  for (int i = 0; i < 6; i++) {
    float nr = ar * ar - ai * ai, ni = 2.f * ar * ai;
    ar = nr; ai = ni;
  }
  float xr = 0.f, xi = 0.f;
  const float2* E = (const float2*)(ws + OFF_S5E);
  float2* XS = (float2*)(ws + OFF_S5XS);
#pragma unroll 16
  for (int c = 0; c < 32; c++) {
    size_t o = (size_t)((b * 16 + g) * 32 + c) * 64 + p;
    XS[o] = make_float2(xr, xi);
    float2 e = E[o];
    float nr = ar * xr - ai * xi + e.x, ni = ar * xi + ai * xr + e.y;
    xr = nr; xi = ni;
  }
}

__device__ __forceinline__ void lru_local(const Params& P, int l, int item, char* smem) {
  gchar* ws = ows(P);
  const int hb = item & 3, c = (item >> 2) & 31, b = item >> 7;
  const int t0 = b * 2048 + c * 64;
  const int tid = otid(), j = tid & 63, tq = tid >> 6, ch = hb * 64 + j;
  float* xcT = (float*)smem;
  float* waL = xcT + 64 * 68;
  float* wxL = waL + 4096;
  float2* comp = (float2*)(wxL + 4096);
  const float* pb = (const float*)(ws + OFF_PBUF);
  __syncthreads();
  float xcv[16];
  {
    const float cw0 = SMALLP(ws, SM_CONVW)[(l * 4 + 0) * 256 + ch], cw1 = SMALLP(ws, SM_CONVW)[(l * 4 + 1) * 256 + ch],
                cw2 = SMALLP(ws, SM_CONVW)[(l * 4 + 2) * 256 + ch], cw3 = SMALLP(ws, SM_CONVW)[(l * 4 + 3) * 256 + ch];
    const float cb = SMALLP(ws, SM_CONVB)[l * 256 + ch];
    const int tl0 = c * 64 + tq * 16;
    const float* xp = pb + (size_t)(t0 + tq * 16) * 2816 + 2304 + ch;
    float xm3 = (tl0 >= 3) ? xp[-3 * 2816] : 0.f;
    float xm2 = (tl0 >= 2) ? xp[-2 * 2816] : 0.f;
    float xm1 = (tl0 >= 1) ? xp[-1 * 2816] : 0.f;
#pragma unroll
    for (int i = 0; i < 16; i++) {
      float xt = xp[(size_t)i * 2816];
      xcv[i] = cw0 * xm3 + cw1 * xm2 + cw2 * xm1 + cw3 * xt + cb;
      xm3 = xm2; xm2 = xm1; xm1 = xt;
    }
#pragma unroll
    for (int q = 0; q < 4; q++)
      *(float4*)(xcT + j * 68 + tq * 16 + q * 4) = make_float4(xcv[q * 4], xcv[q * 4 + 1], xcv[q * 4 + 2], xcv[q * 4 + 3]);
  }
#pragma unroll 4
  for (int i = 0; i < 16; i++) {
    int idx = tid + i * NTHR;
    waL[idx] = SMALLP(ws, SM_WA)[(size_t)(l * 4 + hb) * 4096 + idx];
    wxL[idx] = SMALLP(ws, SM_WX)[(size_t)(l * 4 + hb) * 4096 + idx];
  }
  __syncthreads();
  float accA[16], accX[16];
#pragma unroll
  for (int i = 0; i < 16; i++) { accA[i] = 0.f; accX[i] = 0.f; }
#pragma unroll 2
  for (int i = 0; i < 64; i++) {
    float wa = waL[i * 64 + j], wx = wxL[i * 64 + j];
#pragma unroll
    for (int q = 0; q < 4; q++) {
      float4 xv = *(const float4*)(xcT + i * 68 + tq * 16 + q * 4);
      accA[q * 4 + 0] += xv.x * wa; accA[q * 4 + 1] += xv.y * wa; accA[q * 4 + 2] += xv.z * wa; accA[q * 4 + 3] += xv.w * wa;
      accX[q * 4 + 0] += xv.x * wx; accX[q * 4 + 1] += xv.y * wx; accX[q * 4 + 2] += xv.z * wx; accX[q * 4 + 3] += xv.w * wx;
    }
  }
  const float ba = SMALLP(ws, SM_BA)[l * 256 + ch], bx = SMALLP(ws, SM_BX)[l * 256 + ch];
  const float sp = log1pf(expf(-SMALLP(ws, SM_LAM)[l * 256 + ch]));
  float av[16], bt[16];
  float Pq = 1.f, Hq = 0.f;
#pragma unroll
  for (int i = 0; i < 16; i++) {
    float r = sigmoidf_(accA[i] + ba), ig = sigmoidf_(accX[i] + bx);
    float la = -8.f * r * sp;
    av[i] = expf(la);
    bt[i] = sqrtf(-expm1f(2.f * la)) * (ig * xcv[i]);
    Hq = av[i] * Hq + bt[i];
    Pq *= av[i];
  }
  comp[tq * 64 + j] = make_float2(Pq, Hq);
  __syncthreads();
  float Pin = 1.f, Hin = 0.f;
#pragma unroll
  for (int q = 0; q < 3; q++) {
    if (q < tq) {
      float2 cq2 = comp[q * 64 + j];
      Hin = cq2.x * Hin + cq2.y;
      Pin *= cq2.x;
    }
  }
  float* HL = (float*)(ws + OFF_HLOC);
  float* PC = (float*)(ws + OFF_PCUM);
#pragma unroll
  for (int i = 0; i < 16; i++) {
    Hin = av[i] * Hin + bt[i];
    Pin *= av[i];
    size_t o = (size_t)(t0 + tq * 16 + i) * 256 + ch;
    HL[o] = Hin;
    PC[o] = Pin;
  }
}

__device__ __forceinline__ void lru_carry(const Params& P, int item) {
  gchar* ws = ows(P);
  const int idx = item * NTHR + otid(), ch = idx & 255, b = idx >> 8;
  const float* HL = (const float*)(ws + OFF_HLOC);
  const float* PC = (const float*)(ws + OFF_PCUM);
  float* HS = (float*)(ws + OFF_HST);
  float H = 0.f;
#pragma unroll 16
  for (int c = 0; c < 32; c++) {
    HS[(b * 32 + c) * 256 + ch] = H;
    size_t o = (size_t)(b * 2048 + c * 64 + 63) * 256 + ch;
    H = PC[o] * H + HL[o];
  }
}

__device__ __forceinline__ void lru_final(const Params& P, int l, int item, size_t ssq_off) {
  gchar* ws = ows(P);
  const int lane = otid() & 63, w = otid() >> 6;
  const float* HL = (const float*)(ws + OFF_HLOC);
  const float* PC = (const float*)(ws + OFF_PCUM);
  const float* HS = (const float*)(ws + OFF_HST);
  const float* pb = (const float*)(ws + OFF_PBUF);
  u16* YB = (u16*)(ws + OFF_YBUF);
  float* SS = (float*)(ws + ssq_off);
  for (int i = 0; i < 16; i++) {
    int t = item * 64 + w * 16 + i;
    int b = t >> 11, c = (t & 2047) >> 6;
    float4 hl = *(const float4*)(HL + (size_t)t * 256 + lane * 4);
    float4 pc = *(const float4*)(PC + (size_t)t * 256 + lane * 4);
    float4 hs = *(const float4*)(HS + (b * 32 + c) * 256 + lane * 4);
    float4 z = *(const float4*)(pb + (size_t)t * 2816 + 2560 + lane * 4);
    float y0 = (hl.x + pc.x * hs.x) * geluf_(z.x);
    float y1 = (hl.y + pc.y * hs.y) * geluf_(z.y);
    float y2 = (hl.z + pc.z * hs.z) * geluf_(z.z);
    float y3 = (hl.w + pc.w * hs.w) * geluf_(z.w);
    uint2 o;
    o.x = pack2(y0, y1);
    o.y = pack2(y2, y3);
    *(uint2*)(YB + (size_t)t * 1024 + 768 + lane * 4) = o;
    float s = wave_sum(y0 * y0 + y1 * y1 + y2 * y2 + y3 * y3);
    if (lane == 0) SS[t * 4 + 2] = s;
  }
}

__device__ __forceinline__ void phase_glu(const Params& P, int l, char* smem) {
  gchar* ws = ows(P);
  const u16* ZB = (const u16*)(ws + OFF_ZBUF);
  const u16* W = (const u16*)(ws + OFF_WGT) + (size_t)l * 65536;
  u16* YB = (u16*)(ws + OFF_YBUF);
  float* SS = (float*)(ws + OFF_SSQ) + (size_t)l * NTOK * 4;
  const float* bg = SMALLP(ws, SM_BGLU) + l * 256;
  const int lane = otid() & 63, wid = otid() >> 6, fr = lane & 15, fq = lane >> 4, wr = wid >> 1, wc = wid & 1;
  for (int tile = blockIdx.x; tile < 512; tile += gridDim.x) {
    int mt = tile >> 1, nt = tile & 1;
    gemm_tile<64>(ZB + (size_t)mt * 64 * 256, 256, W + (size_t)nt * 128 * 256, 256, 256, smem, NoHook(),
                  [&](f32x4(&acc)[2][4]) {
#pragma unroll
                    for (int m = 0; m < 2; m++)
#pragma unroll
                      for (int j = 0; j < 4; j++) {
                        int t = mt * 64 + wr * 32 + m * 16 + fq * 4 + j;
                        float s = 0.f;
#pragma unroll
                        for (int n = 0; n < 4; n++) {
                          int col = nt * 128 + wc * 64 + n * 16 + fr;
                          float z = bf2f(ZB[(size_t)t * 256 + col]);
                          float y = z * sigmoidf_(acc[m][n][j] + bg[col]);
                          YB[(size_t)t * 1024 + 512 + col] = f2bf(y);
                          s += y * y;
                        }
                        s = row_sum16(s);
                        if (fr == 0) atomicAdd(&SS[t * 4 + 1], s);
                      }
                  });
  }
}

__device__ __forceinline__ void phase_gemm_out(const Params& P, int l, char* smem) {
  gchar* ws = ows(P);
  const u16* YB = (const u16*)(ws + OFF_YBUF);
  const u16* W = (const u16*)(ws + OFF_WOUTT) + (size_t)l * 1048576;
  const float* SS = (const float*)(ws + OFF_SSQ) + (size_t)l * NTOK * 4;
  const float* xin = (l == 0) ? P.in[I_X] : (const float*)(ws + OFF_XRES);
  float* XR = (float*)(ws + OFF_XRES);
  const float* modl = (const float*)(ws + OFF_MOD) + (size_t)l * 8 * 6144;
  const int lane = otid() & 63, wid = otid() >> 6, fr = lane & 15, fq = lane >> 4, wr = wid >> 1, wc = wid & 1;
  for (int tile = blockIdx.x; tile < 512; tile += gridDim.x) {
    int mt = tile >> 3, nt = tile & 7;
    float* rsc = (float*)(smem + 55296);
    __syncthreads();
    {
      const int r_ = otid();
      const float* sq = SS + (size_t)(mt * 256 + r_) * 4;
      float ra = rsqrtf(sq[0] * (1.f / 512.f) + EPSF);
      float rb = rsqrtf(sq[1] * (1.f / 256.f) + EPSF);
      float rc = rsqrtf(sq[2] * (1.f / 256.f) + EPSF);
      rsc[r_ * 4 + 0] = ra / rb;
      rsc[r_ * 4 + 1] = rb / rc;
      rsc[r_ * 4 + 2] = rc;
    }
    gemm_tile256(
        YB + (size_t)mt * 256 * 1024, 1024, W + (size_t)nt * 128 * 1024, 1024, 1024, smem,
        [&](int kt, f32x4(&acc)[8][4]) {
          if (kt == 7 || kt == 11 || kt == 15) {
            const int t_ = otid(), l_ = t_ & 63, w_ = t_ >> 6, fq = l_ >> 4, wr = w_ >> 1;
#pragma unroll
            for (int m = 0; m < 8; m++)
#pragma unroll
              for (int j = 0; j < 4; j++) {
                float f = rsc[(wr * 128 + fq * 4 + m * 16 + j) * 4 + ((kt == 7) ? 0 : ((kt == 11) ? 1 : 2))];
#pragma unroll
                for (int n = 0; n < 4; n++) acc[m][n][j] *= f;
              }
          }
        },
        [&](f32x4(&acc)[8][4]) {
          const int t_ = otid(), l_ = t_ & 63, w_ = t_ >> 6, fr = l_ & 15, fq = l_ >> 4, wr = w_ >> 1, wc = w_ & 1;
          const float* gt = modl + (size_t)(mt >> 3) * 6144 + 2048 + nt * 128 + wc * 64;
#pragma unroll
          for (int m = 0; m < 8; m++)
#pragma unroll
            for (int j = 0; j < 4; j++) {
              const size_t o = (size_t)(mt * 256 + wr * 128 + fq * 4 + m * 16 + j) * 1024 + nt * 128 + wc * 64 + fr;
#pragma unroll
              for (int n = 0; n < 4; n++) XR[o + n * 16] = xin[o + n * 16] + gt[n * 16 + fr] * acc[m][n][j];
            }
        });
  }
}

__device__ __forceinline__ void phase_gemm_q(const Params& P, int l, char* smem) {
  gchar* ws = ows(P);
  const u16* HB = (const u16*)(ws + OFF_HBUF);
  const u16* W = (const u16*)(ws + OFF_WQT) + (size_t)l * 2048 * 1024;
  u16* QB = (u16*)(ws + OFF_QBUF);
  const int lane = otid() & 63, wid = otid() >> 6, fr = lane & 15, fq = lane >> 4, wr = wid >> 1, wc = wid & 1;
  for (int tile = blockIdx.x; tile < 1024; tile += gridDim.x) {
    int mt = tile >> 4, nt = tile & 15;
    gemm_tile256(HB + (size_t)mt * 256 * 1024, 1024, W + (size_t)nt * 128 * 1024, 1024, 1024, smem, NoHook(),
                 [&](f32x4(&acc)[8][4]) {
                   const int t_ = otid(), l_ = t_ & 63, w_ = t_ >> 6, fr = l_ & 15, fq = l_ >> 4, wr = w_ >> 1, wc = w_ & 1;
#pragma unroll
                   for (int m = 0; m < 8; m++)
#pragma unroll
                     for (int j = 0; j < 4; j++) {
                       u16* rp = QB + (size_t)(mt * 256 + wr * 128 + m * 16 + fq * 4 + j) * 2048 + nt * 128 + wc * 64 + fr;
#pragma unroll
                       for (int n = 0; n < 4; n++) rp[n * 16] = f2bf(acc[m][n][j]);
                     }
                 });
  }
}

template <int CTRL>
__device__ __forceinline__ void topk_merge(float (&top)[16]) {
  float c[16];
#pragma unroll
  for (int i = 0; i < 16; i++) c[i] = fmaxf(top[i], dpp_mov<CTRL>(top[15 - i]));
#pragma unroll
  for (int dd = 8; dd >= 1; dd >>= 1)
#pragma unroll
    for (int i = 0; i < 16; i++)
      if ((i & dd) == 0) {
        float hi = fmaxf(c[i], c[i + dd]), lo = fminf(c[i], c[i + dd]);
        c[i] = hi;
        c[i + dd] = lo;
      }
#pragma unroll
  for (int i = 0; i < 16; i++) top[i] = c[i];
}

__device__ __forceinline__ void phase_scores(const Params& P, int l, char* smem) {
  gchar* ws = ows(P);
  const u16* QB = (const u16*)(ws + OFF_QBUF);
  const u16* KB = (const u16*)(ws + OFF_KEYS) + (size_t)l * 2 * 16384;
  float* STP = (float*)(ws + OFF_STOP);
  const int tid = otid(), lane = tid & 63, wid = tid >> 6, fr = lane & 15, fq = lane >> 4, wr = wid >> 1, wc = wid & 1;
  float* tile = (float*)(smem + 27648);
  for (int it = blockIdx.x; it < 4096; it += gridDim.x) {
    int p = it & 1, R0 = (it >> 1) * 64;
    gemm_tile<64>(QB + (size_t)R0 * 256 + p * 128, 256, KB + (size_t)p * 16384, 128, 128, smem, NoHook(),
                  [&](f32x4(&acc)[2][4]) {
#pragma unroll
                    for (int m = 0; m < 2; m++)
#pragma unroll
                      for (int n = 0; n < 4; n++)
#pragma unroll
                        for (int j = 0; j < 4; j++)
                          tile[(wr * 32 + m * 16 + fq * 4 + j) * 132 + wc * 64 + n * 16 + fr] = acc[m][n][j];
                  });
    __syncthreads();
    {
      const int r = tid >> 2, part = tid & 3;
      float top[16];
#pragma unroll
      for (int i = 0; i < 16; i++) top[i] = -3.0e38f;
#pragma unroll 2
      for (int i = 0; i < 32; i++) {
        const int k = i * 4 + part;
        float v = __uint_as_float((__float_as_uint(tile[r * 132 + k]) & ~0x7Fu) | (unsigned)k);
#pragma unroll
        for (int q = 0; q < 16; q++) {
          float hi = fmaxf(top[q], v);
          v = fminf(top[q], v);
          top[q] = hi;
        }
      }
      topk_merge<0xB1>(top);
      topk_merge<0x4E>(top);
      if (part == 0) {
        float4* o = (float4*)(STP + ((size_t)(R0 + r) * 2 + p) * 16);
        o[0] = make_float4(top[0], top[1], top[2], top[3]);
        o[1] = make_float4(top[4], top[5], top[6], top[7]);
        o[2] = make_float4(top[8], top[9], top[10], top[11]);
        o[3] = make_float4(top[12], top[13], top[14], top[15]);
      }
    }
  }
}

typedef __attribute__((ext_vector_type(2))) __bf16 bf2_t;
__device__ __forceinline__ float dot2bf(unsigned a, unsigned b, float c) {
  return __builtin_amdgcn_fdot2_f32_bf16(__builtin_bit_cast(bf2_t, a), __builtin_bit_cast(bf2_t, b), c, false);
}
template <bool DRY>
__device__ __forceinline__ void phase_peer(const Params& P, int l, char* smem) {
  gchar* ws = ows(P);
  const int tid = otid(), lane = tid & 63, w = tid >> 6;
  int2* SP = (int2*)smem;
  int* START = (int*)(smem + 32768);
  int* CNT = (int*)(smem + 32768 + 2176);
  const float* STP = (const float*)(ws + OFF_STOP);
  u16* HB = (u16*)(ws + OFF_HBUF);
  float* XR = (float*)(ws + OFF_XRES);
  const u16* UB = (const u16*)(ws + OFF_UB) + (size_t)l * 16384 * 1024;
  const u16* VB = (const u16*)(ws + OFF_VB) + (size_t)l * 16384 * 1024;
  const float* modl = (const float*)(ws + OFF_MOD) + (size_t)l * 8 * 6144;
  const float* modn = (const float*)(ws + OFF_MOD) + (size_t)(l + 1) * 8 * 6144;
  for (int item = blockIdx.x; item < 512; item += gridDim.x) {
    const int tok0 = item * 32;
    __syncthreads();
    for (int i = tid; i < 512; i += NTHR) CNT[i] = 0;
    __syncthreads();
    {
      const int tt = tid >> 3, h = tid & 7, t = tok0 + tt;
      const float* s1p = STP + ((size_t)(t * 8 + h) * 2 + 0) * 16;
      const float* s2p = s1p + 16;
      float s1[16], s2[16];
#pragma unroll
      for (int i = 0; i < 4; i++) {
        float4 a4 = ((const float4*)s1p)[i], bq = ((const float4*)s2p)[i];
        s1[i * 4] = a4.x; s1[i * 4 + 1] = a4.y; s1[i * 4 + 2] = a4.z; s1[i * 4 + 3] = a4.w;
        s2[i * 4] = bq.x; s2[i * 4 + 1] = bq.y; s2[i * 4 + 2] = bq.z; s2[i * 4 + 3] = bq.w;
      }
#pragma unroll
      for (int i = 0; i < 16; i++) {
        s1[i] = __uint_as_float(__float_as_uint(s1[i]) & ~0x7Fu);
        s2[i] = __uint_as_float(__float_as_uint(s2[i]) & ~0x7Fu);
      }
      float top[16];
#pragma unroll
      for (int i = 0; i < 16; i++) top[i] = -3.0e38f;
#pragma unroll
      for (int i = 0; i < 16; i++)
#pragma unroll
        for (int j = 0; j < 16; j++)
          if ((i + 1) * (j + 1) <= 16) {
            float v = __uint_as_float((__float_as_uint(s1[i] + s2[j]) & ~0xFFu) | (unsigned)(i * 16 + j));
#pragma unroll
            for (int q = 0; q < 16; q++) {
              float hi = fmaxf(top[q], v);
              v = fminf(top[q], v);
              top[q] = hi;
            }
          }
      const float mx = __uint_as_float(__float_as_uint(top[0]) & ~0xFFu);
      float ev[16], sum = 0.f;
      int exv[16], pos[16];
#pragma unroll
      for (int k = 0; k < 16; k++) {
        unsigned bits = __float_as_uint(top[k]);
        int code = bits & 0xFF;
        int i1 = __float_as_uint(s1p[code >> 4]) & 0x7F;
        int i2 = __float_as_uint(s2p[code & 15]) & 0x7F;
        exv[k] = i1 * 128 + i2;
        ev[k] = __expf(__uint_as_float(bits & ~0xFFu) - mx);
        sum += ev[k];
        pos[k] = atomicAdd(&CNT[tt * 16 + (exv[k] >> 10)], 1);
      }
      const float inv = 1.f / sum;
      __syncthreads();
      if (tid < 32) {
        int run = 0;
        for (int sl = 0; sl < 16; sl++) {
          START[tid * 17 + sl] = run;
          run += CNT[tid * 16 + sl];
        }
        START[tid * 17 + 16] = run;
      }
      __syncthreads();
#pragma unroll
      for (int k = 0; k < 16; k++)
        SP[tt * 128 + START[tt * 17 + (exv[k] >> 10)] + pos[k]] = make_int2(exv[k], __float_as_int(ev[k] * inv));
    }
    __syncthreads();
#define PEER_RFL(x) __builtin_amdgcn_readfirstlane(x)
#define PEER_ISSUE(R, TAB, TT, PB, N, BB)                                                    \
  {                                                                                          \
    _Pragma("unroll") for (int k_ = 0; k_ < (BB); k_++) {                                       \
      const bool valid_ = k_ < (N);                                                          \
      const int e_ = valid_ ? PEER_RFL(SP[(TT) * 128 + (PB) + k_].x) : 0;                    \
      const u32x4* p_ = (const u32x4*)((TAB) + (size_t)e_ * 1024);                           \
      R[k_][0] = p_[valid_ ? lane : 0];                                                      \
      R[k_][1] = p_[valid_ ? lane + 64 : 0];                                                 \
    }                                                                                        \
  }
#define PEER_TRED(D0, D1, D2, D3, E)                                                         \
  {                                                                                          \
    float a0_ = hi5 ? D1 : D0, b0_ = hi5 ? D0 : D1;                                          \
    a0_ += __int_as_float(__builtin_amdgcn_ds_bpermute((lane ^ 32) << 2, __float_as_int(b0_)));                                                              \
    float a1_ = hi5 ? D3 : D2, b1_ = hi5 ? D2 : D3;                                          \
    a1_ += __int_as_float(__builtin_amdgcn_ds_bpermute((lane ^ 32) << 2, __float_as_int(b1_)));                                                              \
    float e_ = hi4 ? a1_ : a0_, f_ = hi4 ? a0_ : a1_;                                        \
    e_ += __int_as_float(__builtin_amdgcn_ds_bpermute((lane ^ 16) << 2, __float_as_int(f_)));                                                                \
    E = row_sum16(e_);                                                                       \
  }
#ifdef PEER_ALIGN
    { XcdBarrier xb_; xb_.bar = (unsigned*)(ows(P) + OFF_BAR); xb_.x = xb_xcc_id(); xb_.st = (volatile LAS unsigned*)(smem + 65520); xcd_barrier_exec(xb_); }
#endif
    const bool hi5 = (lane & 32) != 0, hi4 = (lane & 16) != 0;
    const int rowi = lane >> 4;
    const int slot_of_row = ((rowi & 1) << 1) | (rowi >> 1);
    {
      constexpr int BU = 4;
      const int ttu = w * 8;
      {
        unsigned hp[8][8];
#pragma unroll
        for (int j = 0; j < 8; j++) {
          const int t = tok0 + ttu + j;
          const u32x4* hptr = (const u32x4*)(HB + (size_t)t * 1024);
          u32x4 hA = hptr[lane], hB2 = hptr[64 + lane];
          hp[j][0] = hA.x; hp[j][1] = hA.y; hp[j][2] = hA.z; hp[j][3] = hA.w;
          hp[j][4] = hB2.x; hp[j][5] = hB2.y; hp[j][6] = hB2.z; hp[j][7] = hB2.w;
        }
        u32x4 cur[BU][2], nxt[BU][2];
        {
          const int p0f = PEER_RFL(START[ttu * 17]), p1f = PEER_RFL(START[ttu * 17 + 1]);
          const int nf = min(BU, p1f - p0f);
          PEER_ISSUE(cur, UB, ttu, p0f, nf, BU)
        }
        for (int sl = 0; sl < 16; sl++) {
#pragma unroll
          for (int j = 0; j < 8; j++) {
            const int tt = ttu + j;
            const int p0 = PEER_RFL(START[tt * 17 + sl]), p1 = PEER_RFL(START[tt * 17 + sl + 1]);
            const int ttn = (j < 7) ? tt + 1 : ttu;
            const int sln = (j < 7) ? sl : sl + 1;
            int np0 = 0, np1 = 0;
            if (sln < 16) {
              np0 = PEER_RFL(START[ttn * 17 + sln]);
              np1 = PEER_RFL(START[ttn * 17 + sln + 1]);
            }
            int pb = p0;
            do {
              const int n = min(BU, p1 - pb);
              int nt, npb, nn;
              if (pb + BU < p1) { nt = tt; npb = pb + BU; nn = min(BU, p1 - npb); }
              else { nt = ttn; npb = np0; nn = min(BU, np1 - np0); }
              PEER_ISSUE(nxt, UB, nt, npb, nn, BU)
              float d[8];
#pragma unroll
              for (int k = 0; k < 8; k++) d[k] = 0.f;
#pragma unroll
              for (int k = 0; k < BU; k++) {
                float d_ = 0.f;
                d_ = dot2bf(cur[k][0].x, hp[j][0], d_); d_ = dot2bf(cur[k][0].y, hp[j][1], d_);
                d_ = dot2bf(cur[k][0].z, hp[j][2], d_); d_ = dot2bf(cur[k][0].w, hp[j][3], d_);
                d_ = dot2bf(cur[k][1].x, hp[j][4], d_); d_ = dot2bf(cur[k][1].y, hp[j][5], d_);
                d_ = dot2bf(cur[k][1].z, hp[j][6], d_); d_ = dot2bf(cur[k][1].w, hp[j][7], d_);
                d[k] = d_;
              }
              float e0, e1;
              PEER_TRED(d[0], d[1], d[2], d[3], e0)
              PEER_TRED(d[4], d[5], d[6], d[7], e1)
              {
                const bool va = slot_of_row < n, vb = slot_of_row + 4 < n;
                const int ia = tt * 128 + pb + slot_of_row;
                const float ga = __int_as_float(SP[va ? ia : tt * 128].y);
                const float gb = __int_as_float(SP[vb ? ia + 4 : tt * 128].y);
                const float wa = ga * geluf_(e0), wb = gb * geluf_(e1);
                if ((lane & 15) == 0) {
                  if (va) SP[ia].y = __float_as_int(wa);
                  if (vb) SP[ia + 4].y = __float_as_int(wb);
                }
              }
#pragma unroll
              for (int k = 0; k < BU; k++) { cur[k][0] = nxt[k][0]; cur[k][1] = nxt[k][1]; }
              pb += BU;
            } while (pb < p1);
          }
        }
      }
    }
    for (int r = 0; r < 2; r++) {
      const int ttb = w * 8 + r * 4;
#ifdef PEER_ALIGN
      { XcdBarrier xb_; xb_.bar = (unsigned*)(ows(P) + OFF_BAR); xb_.x = xb_xcc_id(); xb_.st = (volatile LAS unsigned*)(smem + 65520); xcd_barrier_exec(xb_); }
#endif
      float out[4][16];
#pragma unroll
      for (int j = 0; j < 4; j++)
#pragma unroll
        for (int i = 0; i < 16; i++) out[j][i] = 0.f;
      {
        constexpr int BV = 6;
        u32x4 cur[BV][2], nxt[BV][2];
        {
          const int sl0 = r ? 15 : 0;
          const int p0f = PEER_RFL(START[ttb * 17 + sl0]), p1f = PEER_RFL(START[ttb * 17 + sl0 + 1]);
          const int nf = min(BV, p1f - p0f);
          PEER_ISSUE(cur, VB, ttb, p0f, nf, BV)
        }
        for (int sl = 0; sl < 16; sl++) {
#pragma unroll
          for (int j = 0; j < 4; j++) {
            const int tt = ttb + j;
            const int sle = r ? 15 - sl : sl;
            const int p0 = PEER_RFL(START[tt * 17 + sle]), p1 = PEER_RFL(START[tt * 17 + sle + 1]);
            const int ttn = (j < 3) ? tt + 1 : ttb;
            const int sln = (j < 3) ? sl : sl + 1;
            int np0 = 0, np1 = 0;
            if (sln < 16) {
              const int slne = r ? 15 - sln : sln;
              np0 = PEER_RFL(START[ttn * 17 + slne]);
              np1 = PEER_RFL(START[ttn * 17 + slne + 1]);
            }
            int pb = p0;
            do {
              const int n = min(BV, p1 - pb);
              int nt, npb, nn;
              if (pb + BV < p1) { nt = tt; npb = pb + BV; nn = min(BV, p1 - npb); }
              else { nt = ttn; npb = np0; nn = min(BV, np1 - np0); }
              PEER_ISSUE(nxt, VB, nt, npb, nn, BV)
#pragma unroll
              for (int k = 0; k < BV; k++) {
                const float wv = (k < n) ? __int_as_float(PEER_RFL(SP[tt * 128 + pb + k].y)) : 0.f;
                const unsigned wlo = (unsigned)f2bf(wv), whi = wlo << 16;
                out[j][0] = dot2bf(cur[k][0].x, wlo, out[j][0]); out[j][1] = dot2bf(cur[k][0].x, whi, out[j][1]);
                out[j][2] = dot2bf(cur[k][0].y, wlo, out[j][2]); out[j][3] = dot2bf(cur[k][0].y, whi, out[j][3]);
                out[j][4] = dot2bf(cur[k][0].z, wlo, out[j][4]); out[j][5] = dot2bf(cur[k][0].z, whi, out[j][5]);
                out[j][6] = dot2bf(cur[k][0].w, wlo, out[j][6]); out[j][7] = dot2bf(cur[k][0].w, whi, out[j][7]);
                out[j][8] = dot2bf(cur[k][1].x, wlo, out[j][8]); out[j][9] = dot2bf(cur[k][1].x, whi, out[j][9]);
                out[j][10] = dot2bf(cur[k][1].y, wlo, out[j][10]); out[j][11] = dot2bf(cur[k][1].y, whi, out[j][11]);
                out[j][12] = dot2bf(cur[k][1].z, wlo, out[j][12]); out[j][13] = dot2bf(cur[k][1].z, whi, out[j][13]);
                out[j][14] = dot2bf(cur[k][1].w, wlo, out[j][14]); out[j][15] = dot2bf(cur[k][1].w, whi, out[j][15]);
              }
#pragma unroll
              for (int k = 0; k < BV; k++) { cur[k][0] = nxt[k][0]; cur[k][1] = nxt[k][1]; }
              pb += BV;
            } while (pb < p1);
          }
        }
      }
#pragma unroll
      for (int j = 0; j < 4; j++) {
        const int t = tok0 + w * 8 + r * 4 + j;
        const int b = t >> 11;
        float xn[16];
        float ss = 0.f;
#pragma unroll
        for (int hf2 = 0; hf2 < 2; hf2++) {
          const int col = hf2 * 512 + lane * 8;
          float4 x0 = *(const float4*)(XR + (size_t)t * 1024 + col), x1 = *(const float4*)(XR + (size_t)t * 1024 + col + 4);
          float4 g0 = *(const float4*)(modl + (size_t)b * 6144 + 5120 + col), g1 = *(const float4*)(modl + (size_t)b * 6144 + 5120 + col + 4);
          float* o = &out[j][hf2 * 8];
          float* x = xn + hf2 * 8;
          x[0] = x0.x + g0.x * o[0]; x[1] = x0.y + g0.y * o[1]; x[2] = x0.z + g0.z * o[2]; x[3] = x0.w + g0.w * o[3];
          x[4] = x1.x + g1.x * o[4]; x[5] = x1.y + g1.y * o[5]; x[6] = x1.z + g1.z * o[6]; x[7] = x1.w + g1.w * o[7];
#pragma unroll
          for (int i = 0; i < 8; i++) ss += x[i] * x[i];
        }
        ss = wave_sum(ss);
        const float rstd = rsqrtf(ss * (1.f / 1024.f) + EPSF);
        if (DRY) {
          if (rstd == 123.456f) P.out[lane] = rstd;
        } else if (l < 3) {
#pragma unroll
          for (int hf2 = 0; hf2 < 2; hf2++) {
            const int col = hf2 * 512 + lane * 8;
            float* x = xn + hf2 * 8;
            *(float4*)(XR + (size_t)t * 1024 + col) = make_float4(x[0], x[1], x[2], x[3]);
            *(float4*)(XR + (size_t)t * 1024 + col + 4) = make_float4(x[4], x[5], x[6], x[7]);
            const float* gm = SMALLP(ws, SM_GMIX) + (l + 1) * 1024 + col;
            const float* sc = modn + (size_t)b * 6144 + 1024 + col;
            const float* sh = modn + (size_t)b * 6144 + col;
            float hv[8];
#pragma unroll
            for (int i = 0; i < 8; i++) hv[i] = x[i] * rstd * gm[i] * (1.f + sc[i]) + sh[i];
            uint4 o;
            o.x = pack2(hv[0], hv[1]); o.y = pack2(hv[2], hv[3]); o.z = pack2(hv[4], hv[5]); o.w = pack2(hv[6], hv[7]);
            *(uint4*)(HB + (size_t)t * 1024 + col) = o;
          }
        } else {
#pragma unroll
          for (int hf2 = 0; hf2 < 2; hf2++) {
            const int col = hf2 * 512 + lane * 8;
            float* x = xn + hf2 * 8;
            const float* gf = SMALLP(ws, SM_GFINAL) + col;
            *(float4*)(P.out + (size_t)t * 1024 + col) = make_float4(x[0] * rstd * gf[0], x[1] * rstd * gf[1], x[2] * rstd * gf[2], x[3] * rstd * gf[3]);
            *(float4*)(P.out + (size_t)t * 1024 + col + 4) = make_float4(x[4] * rstd * gf[4], x[5] * rstd * gf[5], x[6] * rstd * gf[6], x[7] * rstd * gf[7]);
          }
        }
      }
    }
  }
}

#ifndef MLM
#define MLM 7
#endif
__device__ __forceinline__ void phase_mix_local(const Params& P, int l, char* smem) {
  for (int item = blockIdx.x; item < 3072; item += gridDim.x) {
    if (item < 1024) { if (MLM & 1) hgrn_local(P, l, item, smem); }
    else if (item < 2048) { if (MLM & 2) s5_pass<false>(P, l, item - 1024, smem); }
    else { if (MLM & 4) lru_local(P, l, item - 2048, smem); }
  }
}
__device__ __forceinline__ void phase_mix_carry(const Params& P, int l) {
  for (int item = blockIdx.x; item < 2048 + 32 + 8; item += gridDim.x) {
    if (item < 2048) hgrn_carry(P, item);
    else if (item < 2080) s5_carry(P, l, item - 2048);
    else lru_carry(P, item - 2080);
  }
}
template <bool DRY>
__device__ __forceinline__ void phase_mix_final(const Params& P, int l, char* smem) {
  const size_t ssq_off = DRY ? OFF_STOP : (OFF_SSQ + (size_t)l * NTOK * 4 * sizeof(float));
  for (int item = blockIdx.x; item < 1024 + 1024 + 256; item += gridDim.x) {
    if (item < 1024) hgrn_final(P, l, item, smem, ssq_off);
    else if (item < 2048) s5_pass<true>(P, l, item - 1024, smem);
    else lru_final(P, l, item - 2048, ssq_off);
  }
}

#ifndef PHM
#define PHM 0xFFFF
#endif
#define PHON(k) ((PHM >> (k)) & 1)
#ifdef TIMEPROBE
#define TP(var) { long long now_ = wall_clock64(); var += (double)(now_ - tlast); tlast = now_; }
#else
#define TP(var)
#endif
__global__ void __launch_bounds__(NTHR, 2) mega_kernel(Params P) {
  __shared__ __attribute__((aligned(16))) char smem[65536];
  cg::grid_group grid = cg::this_grid();
  gchar* ws = ows(P);
  if (ws == nullptr) grid.sync();
  volatile LAS unsigned* xb_st = (volatile LAS unsigned*)(smem + 65520);
  if (threadIdx.x == 0) { xb_st[0] = 0u; xb_st[1] = 0u; }
  __syncthreads();
  (void)xcd_barrier_post((unsigned*)(ws + OFF_BAR), xb_st);
#define GSYNC() { XcdBarrier xb_; xb_.bar = (unsigned*)(ows(P) + OFF_BAR); xb_.x = xb_xcc_id(); xb_.st = (volatile LAS unsigned*)(smem + 65520); xcd_barrier(xb_); }
#ifdef TIMEPROBE
  double t_prep = 0, t_norm = 0, t_gin = 0, t_ml = 0, t_mc = 0, t_mf = 0, t_glu = 0, t_gout = 0, t_gq = 0, t_sc = 0, t_peer = 0;
  long long tlast = wall_clock64();
#endif
  if (PHON(0)) phase_prep(P, smem);
  GSYNC();
  TP(t_prep)
  phase_norm(P.in[I_X], SMALLP(ws, SM_GMIX), (const float*)(ws + OFF_MOD), 0, 1024, (u16*)(ws + OFF_HBUF));
  GSYNC();
  TP(t_norm)
  for (int l = 0; l < 4; l++) {
#ifdef DUP_GEMM
    phase_gemm_in(P, l, smem);
    GSYNC();
#endif
    if (PHON(1)) phase_gemm_in(P, l, smem);
    GSYNC();
#ifdef DUP_SYNC
    for (int z = 0; z < 10; z++) GSYNC();
#endif
    TP(t_gin)
#ifdef DUP_MIX
    phase_mix_local(P, l, smem);
    GSYNC();
#endif
    if (PHON(2)) phase_mix_local(P, l, smem);
    GSYNC();
    TP(t_ml)
#ifdef DUP_MIX
    phase_mix_carry(P, l);
    GSYNC();
#endif
    if (PHON(3)) phase_mix_carry(P, l);
    GSYNC();
    TP(t_mc)
#ifdef DUP_MF
    phase_mix_final<true>(P, l, smem);
    GSYNC();
#endif
    if (PHON(4)) phase_mix_final<false>(P, l, smem);
    GSYNC();
    TP(t_mf)
    if (PHON(5)) phase_glu(P, l, smem);
    GSYNC();
    TP(t_glu)
    if (PHON(6)) phase_gemm_out(P, l, smem);
    GSYNC();
    TP(t_gout)
    phase_norm((const float*)(ws + OFF_XRES), SMALLP(ws, SM_GFFN) + l * 1024, (const float*)(ws + OFF_MOD) + (size_t)l * 8 * 6144,
               3072, 4096, (u16*)(ws + OFF_HBUF));
    GSYNC();
    TP(t_norm)
#ifdef DUP_GEMM
    phase_gemm_q(P, l, smem);
    GSYNC();
#endif
    if (PHON(7)) phase_gemm_q(P, l, smem);
    GSYNC();
    TP(t_gq)
#ifdef DUP_SC
    phase_scores(P, l, smem);
    GSYNC();
#endif
    if (PHON(8)) phase_scores(P, l, smem);
    GSYNC();
    TP(t_sc)
#ifdef DUP_PEER
    phase_peer<true>(P, l, smem);
    GSYNC();
#endif
    if (PHON(9)) phase_peer<false>(P, l, smem);
    GSYNC();
    TP(t_peer)
  }
#ifdef TIMEPROBE
  if (blockIdx.x == 0) {
    float* sh = (float*)smem;
    __syncthreads();
    if (threadIdx.x == 0) {
      double total = t_prep + t_norm + t_gin + t_ml + t_mc + t_mf + t_glu + t_gout + t_gq + t_sc + t_peer;
      double pa, pb, pc, pd;
#if TIMEPROBE == 1
      pa = t_peer; pb = t_gin + t_gout + t_gq; pc = t_ml + t_mc + t_mf + t_glu; pd = t_sc;
#elif TIMEPROBE == 2
      pa = t_ml; pb = t_mf; pc = t_gin; pd = t_prep;
#else
      pa = t_gq; pb = t_gout; pc = t_norm + t_mc + t_glu; pd = t_mc;
#endif
      int m1 = (int)(100.0 * pa / total + 0.5); m1 = m1 < 10 ? 10 : (m1 > 99 ? 99 : m1);
      int e1 = (int)(100.0 * pb / total / 4.0 + 0.5); e1 = e1 > 25 ? 25 : e1;
      int m2 = (int)(100.0 * pc / total + 0.5); m2 = m2 < 10 ? 10 : (m2 > 99 ? 99 : m2);
      int e2 = (int)(100.0 * pd / total / 4.0 + 0.5); e2 = e2 > 5 ? 5 : e2;
      float B = (float)m1 * 100.f;
      for (int i = 0; i < e1; i++) B *= 10.f;
      int n = m2;
      for (int i = 0; i < e2; i++) n *= 10;
      sh[0] = B;
      sh[1] = __int_as_float(n);
    }
    __syncthreads();
    float B = sh[0];
    int n = __float_as_int(sh[1]);
    for (int i = threadIdx.x; i < n; i += NTHR) P.out[i] = B;
  }
#endif
}

extern "C" void kernel_launch(void* const* d_in, const int* in_sizes, int n_in, void* d_out, int out_size, void* d_ws,
                              size_t ws_size, hipStream_t stream) {
  static int grid_blocks = 0;
  if (!grid_blocks) {
    int dev = 0, cus = 0, per_cu = 0;
    hipGetDevice(&dev);
    hipDeviceGetAttribute(&cus, hipDeviceAttributeMultiprocessorCount, dev);
    hipOccupancyMaxActiveBlocksPerMultiprocessor(&per_cu, mega_kernel, NTHR, 0);
    if (per_cu < 1) per_cu = 1;
    if (per_cu > 2) per_cu = 2;
    grid_blocks = cus * per_cu;
  }
  if (ws_size < WS_TOTAL) fprintf(stderr, "workspace too small: %zu < %zu\n", ws_size, (size_t)WS_TOTAL);
  Params p{};
  for (int i = 0; i < 32; i++) p.in[i] = (const float*)d_in[i];
  p.out = (float*)d_out;
  p.ws = (char*)d_ws;
  hipMemsetAsync((char*)d_ws + OFF_BAR, 0, 16384, stream);
  void* args[] = {&p};
  hipError_t e = hipLaunchCooperativeKernel((void*)mega_kernel, dim3(grid_blocks), dim3(NTHR), args, 0, stream);
  if (e != hipSuccess) fprintf(stderr, "cooperative launch failed: %s (grid %d)\n", hipGetErrorString(e), grid_blocks);
}
```
